# Optimizing an MI355X kernel written in HIP

```python
import math
import jax, jax.numpy as jnp
from jax import lax
import numpy as np

D_MODEL = 1024
BATCH = 4
SEQ = 4096
DEPTH = 4
DEC_BATCH = 128
DEC_SEQ = 8
PAST_LEN = 8192
PAGE_SIZE = 128

N_MIXERS = 3
N_GMLP_LAYERS = (DEPTH + 2) // 3
N_CONV_LAYERS = (DEPTH + 1) // 3
N_MLA_LAYERS = DEPTH // 3

ALPHA = (2.0 * DEPTH) ** 0.25
BETA = (8.0 * DEPTH) ** -0.25
LN_EPS = 1e-5
RMS_EPS = 1e-6

GMLP_DIM = 2 * D_MODEL
GMLP_GROUPS = 8
GMLP_CHUNK = 128

CONV_WIDTH = 31

MLA_HEADS = 8
MLA_Q_RANK = 384
MLA_KV_RANK = 256
MLA_NOPE = 128
MLA_ROPE = 64
MLA_V = 128
ROPE_THETA = 10000.0
Q_BLOCK = 128
MLA_SCALE = (MLA_NOPE + MLA_ROPE) ** -0.5

FFN_DIM = ((8 * D_MODEL + 3 * 256 - 1) // (3 * 256)) * 256

kernel_name = 'hybrid_gmlp_conformer_mla_adaln_deepnorm_step'


def layer_norm(x, g, b):
    xf = x.astype(jnp.float32)
    mu = jnp.mean(xf, -1, keepdims=True)
    var = jnp.mean(jnp.square(xf - mu), -1, keepdims=True)
    return ((xf - mu) * lax.rsqrt(var + LN_EPS)).astype(x.dtype) * g + b


def rms_norm(x, g):
    xf = x.astype(jnp.float32)
    return (xf * lax.rsqrt(jnp.mean(jnp.square(xf), -1, keepdims=True) + RMS_EPS)).astype(x.dtype) * g


def rope(x, pos):
    half = x.shape[-1] // 2
    inv = ROPE_THETA ** (-jnp.arange(half, dtype=jnp.float32) / half)
    ang = pos.astype(jnp.float32)[:, None] * inv[None, :]
    cos = jnp.cos(ang)[None, :, None, :].astype(x.dtype)
    sin = jnp.sin(ang)[None, :, None, :].astype(x.dtype)
    x1, x2 = x[..., :half], x[..., half:]
    return jnp.concatenate([x1 * cos - x2 * sin, x2 * cos + x1 * sin], -1)


def adaln(c, w, b):
    m = (jax.nn.silu(c) @ w + b).reshape(c.shape[0], 6, 1, D_MODEL)
    return m[:, 0], m[:, 1], m[:, 2], m[:, 3], m[:, 4], m[:, 5]


def swiglu_ffn(h, wg, wu, wd):
    return (jax.nn.silu(h @ wg) * (h @ wu)) @ wd


def gmlp_mixer(h, w_in, ln_g, ln_b, w_s, b_s, w_out):
    bsz, t, _ = h.shape
    z = jax.nn.gelu(h @ w_in, approximate=False)
    u, v = z[..., :GMLP_DIM], z[..., GMLP_DIM:]
    v = layer_norm(v, ln_g, ln_b)
    l = min(t, GMLP_CHUNK)
    n = t // l
    cg = GMLP_DIM // GMLP_GROUPS
    causal = jnp.tril(jnp.ones((l, l), dtype=bool))
    w = jnp.where(causal[None], w_s[:, :l, :l], 0)
    vc = v.reshape(bsz, n, l, GMLP_GROUPS, cg)
    mixed = jnp.einsum('gts,bnsgc->bntgc', w, vc) + b_s[:, :l].T[None, None, :, :, None]
    y = (u * mixed.reshape(bsz, t, GMLP_DIM)) @ w_out
    return y, v


def conv_module(h, ctx, w_pw1, b_pw1, w_dw, b_dw, ln_g, ln_b, w_pw2, b_pw2):
    a = h @ w_pw1 + b_pw1
    a = a[..., :D_MODEL] * jax.nn.sigmoid(a[..., D_MODEL:])
    full = jnp.concatenate([ctx, a], 1)
    y = lax.conv_general_dilated(full, w_dw[:, None, :], window_strides=(1,), padding='VALID',
                                 dimension_numbers=('NWC', 'WIO', 'NWC'),
                                 feature_group_count=D_MODEL) + b_dw
    y = jax.nn.silu(layer_norm(y, ln_g, ln_b))
    return y @ w_pw2 + b_pw2, full[:, -(CONV_WIDTH - 1):]


def mla_project(h, pos, w_down, g_q, g_kv, w_uq, w_uk):
    bsz, t, _ = h.shape
    d = h @ w_down
    q_lat = rms_norm(d[..., :MLA_Q_RANK], g_q)
    ckv = rms_norm(d[..., MLA_Q_RANK:MLA_Q_RANK + MLA_KV_RANK], g_kv)
    kr = rope(d[..., MLA_Q_RANK + MLA_KV_RANK:][:, :, None, :], pos)[:, :, 0]
    q = (q_lat @ w_uq).reshape(bsz, t, MLA_HEADS, MLA_NOPE + MLA_ROPE)
    q_abs = jnp.einsum('bthn,chn->bthc', q[..., :MLA_NOPE], w_uk)
    q_rope = rope(q[..., MLA_NOPE:], pos)
    return q_abs, q_rope, ckv, kr


def mla_out(ctx, w_uv, w_o):
    bsz, t = ctx.shape[:2]
    o = jnp.einsum('bthc,chv->bthv', ctx, w_uv).reshape(bsz, t, MLA_HEADS * MLA_V)
    return o @ w_o


def mla_prompt_attend(q_abs, q_rope, ckv, kr):
    bsz, t = q_abs.shape[:2]
    nb = t // Q_BLOCK
    qa = q_abs.reshape(bsz, nb, Q_BLOCK, MLA_HEADS, MLA_KV_RANK).swapaxes(0, 1)
    qr = q_rope.reshape(bsz, nb, Q_BLOCK, MLA_HEADS, MLA_ROPE).swapaxes(0, 1)
    key_pos = jnp.arange(t)

    def block(args):
        qa_b, qr_b, start = args
        s = (jnp.einsum('bqhc,bkc->bhqk', qa_b, ckv)
             + jnp.einsum('bqhr,bkr->bhqk', qr_b, kr)).astype(jnp.float32) * MLA_SCALE
        q_pos = start + jnp.arange(Q_BLOCK)
        s = jnp.where(key_pos[None, :] <= q_pos[:, None], s, -jnp.inf)
        p = jax.nn.softmax(s, -1).astype(ckv.dtype)
        return jnp.einsum('bhqk,bkc->bqhc', p, ckv)

    ctx = lax.map(block, (qa, qr, jnp.arange(nb) * Q_BLOCK))
    return ctx.swapaxes(0, 1).reshape(bsz, t, MLA_HEADS, MLA_KV_RANK)


def mla_sample_attend(q_abs, q_rope, ckv_new, kr_new, ckv_past, kr_past):
    t = q_abs.shape[1]
    p_len = ckv_past.shape[1]
    s_past = (jnp.einsum('bqhc,bkc->bhqk', q_abs, ckv_past)
              + jnp.einsum('bqhr,bkr->bhqk', q_rope, kr_past)).astype(jnp.float32) * MLA_SCALE
    s_new = (jnp.einsum('bqhc,bkc->bhqk', q_abs, ckv_new)
             + jnp.einsum('bqhr,bkr->bhqk', q_rope, kr_new)).astype(jnp.float32) * MLA_SCALE
    s_new = jnp.where(jnp.tril(jnp.ones((t, t), dtype=bool)), s_new, -jnp.inf)
    p = jax.nn.softmax(jnp.concatenate([s_past, s_new], -1), -1).astype(ckv_new.dtype)
    return (jnp.einsum('bhqk,bkc->bqhc', p[..., :p_len], ckv_past)
            + jnp.einsum('bhqk,bkc->bqhc', p[..., p_len:], ckv_new))


def setup_inputs(seed: int = 0) -> dict:
    key = jax.random.key(seed)
    ks = iter(jax.random.split(key, 48))
    f32 = jnp.float32

    def nrm(shape, scale):
        return jax.random.normal(next(ks), shape, f32) * scale

    def gain(shape):
        return 1.0 + nrm(shape, 0.01)

    n_pages = PAST_LEN // PAGE_SIZE
    n_pool = (DEC_BATCH * n_pages * 5) // 4
    d = D_MODEL
    inputs = {}
    inputs['x_prompt'] = nrm((BATCH, SEQ, d), 1.0)
    inputs['x_sample'] = nrm((DEC_BATCH, DEC_SEQ, d), 1.0)
    inputs['cache_ckv'] = nrm((N_MLA_LAYERS, n_pool, PAGE_SIZE, MLA_KV_RANK), 1.0)
    inputs['cache_krope'] = nrm((N_MLA_LAYERS, n_pool, PAGE_SIZE, MLA_ROPE), 1.0)
    inputs['state_conv'] = nrm((N_CONV_LAYERS, DEC_BATCH, CONV_WIDTH - 1, d), 0.5)
    perm = jax.random.permutation(next(ks), n_pool)[:DEC_BATCH * n_pages]
    inputs['page_table'] = perm.reshape(DEC_BATCH, n_pages).astype(jnp.int32)
    inputs['c_prompt'] = nrm((BATCH, d), 1.0)
    inputs['c_sample'] = nrm((DEC_BATCH, d), 1.0)
    inputs['ada_w'] = nrm((DEPTH, d, 6 * d), d ** -0.5)
    inputs['ada_b'] = nrm((DEPTH, 6 * d), 0.01)
    inputs['ln_mix_g'] = gain((DEPTH, d))
    inputs['ln_mix_b'] = nrm((DEPTH, d), 0.01)
    inputs['ln_ffn_g'] = gain((DEPTH, d))
    inputs['ln_ffn_b'] = nrm((DEPTH, d), 0.01)
    inputs['ffn_w_gate'] = nrm((DEPTH, d, FFN_DIM), d ** -0.5)
    inputs['ffn_w_up'] = nrm((DEPTH, d, FFN_DIM), d ** -0.5 * BETA)
    inputs['ffn_w_down'] = nrm((DEPTH, FFN_DIM, d), FFN_DIM ** -0.5 * BETA)
    inputs['gmlp_w_in'] = nrm((N_GMLP_LAYERS, d, 2 * GMLP_DIM), d ** -0.5)
    inputs['gmlp_ln_g'] = gain((N_GMLP_LAYERS, GMLP_DIM))
    inputs['gmlp_ln_b'] = nrm((N_GMLP_LAYERS, GMLP_DIM), 0.01)
    inputs['gmlp_w_s'] = nrm((N_GMLP_LAYERS, GMLP_GROUPS, GMLP_CHUNK, GMLP_CHUNK), GMLP_CHUNK ** -0.5)
    inputs['gmlp_b_s'] = 1.0 + nrm((N_GMLP_LAYERS, GMLP_GROUPS, GMLP_CHUNK), 0.1)
    inputs['gmlp_w_out'] = nrm((N_GMLP_LAYERS, GMLP_DIM, d), GMLP_DIM ** -0.5 * BETA)
    inputs['conv_w_pw1'] = nrm((N_CONV_LAYERS, d, 2 * d), d ** -0.5)
    inputs['conv_b_pw1'] = nrm((N_CONV_LAYERS, 2 * d), 0.01)
    inputs['conv_w_dw'] = nrm((N_CONV_LAYERS, CONV_WIDTH, d), CONV_WIDTH ** -0.5)
    inputs['conv_b_dw'] = nrm((N_CONV_LAYERS, d), 0.01)
    inputs['conv_ln_g'] = gain((N_CONV_LAYERS, d))
    inputs['conv_ln_b'] = nrm((N_CONV_LAYERS, d), 0.01)
    inputs['conv_w_pw2'] = nrm((N_CONV_LAYERS, d, d), d ** -0.5 * BETA)
    inputs['conv_b_pw2'] = nrm((N_CONV_LAYERS, d), 0.01)
    inputs['mla_w_down'] = nrm((N_MLA_LAYERS, d, MLA_Q_RANK + MLA_KV_RANK + MLA_ROPE), d ** -0.5)
    inputs['mla_g_q'] = gain((N_MLA_LAYERS, MLA_Q_RANK))
    inputs['mla_g_kv'] = gain((N_MLA_LAYERS, MLA_KV_RANK))
    inputs['mla_w_uq'] = nrm((N_MLA_LAYERS, MLA_Q_RANK, MLA_HEADS * (MLA_NOPE + MLA_ROPE)), MLA_Q_RANK ** -0.5)
    inputs['mla_w_uk'] = nrm((N_MLA_LAYERS, MLA_KV_RANK, MLA_HEADS, MLA_NOPE), MLA_KV_RANK ** -0.5)
    inputs['mla_w_uv'] = nrm((N_MLA_LAYERS, MLA_KV_RANK, MLA_HEADS, MLA_V), MLA_KV_RANK ** -0.5 * BETA)
    inputs['mla_w_o'] = nrm((N_MLA_LAYERS, MLA_HEADS * MLA_V, d), (MLA_HEADS * MLA_V) ** -0.5 * BETA)
    return inputs


def reference(x_prompt, x_sample, cache_ckv, cache_krope, state_conv, page_table, c_prompt, c_sample,
              ada_w, ada_b, ln_mix_g, ln_mix_b, ln_ffn_g, ln_ffn_b, ffn_w_gate, ffn_w_up, ffn_w_down,
              gmlp_w_in, gmlp_ln_g, gmlp_ln_b, gmlp_w_s, gmlp_b_s, gmlp_w_out,
              conv_w_pw1, conv_b_pw1, conv_w_dw, conv_b_dw, conv_ln_g, conv_ln_b, conv_w_pw2, conv_b_pw2,
              mla_w_down, mla_g_q, mla_g_kv, mla_w_uq, mla_w_uk, mla_w_uv, mla_w_o):
    dec_b = x_sample.shape[0]
    past_len = page_table.shape[1] * cache_ckv.shape[2]
    pos_p = jnp.arange(x_prompt.shape[1])
    pos_s = past_len + jnp.arange(x_sample.shape[1])
    xp, xs = x_prompt, x_sample
    ckv_p_rows, kr_p_rows, ckv_s_rows, kr_s_rows = [], [], [], []
    conv_p_states, conv_s_states, gmlp_v_rows = [], [], []
    for i in range(DEPTH):
        kind, j = i % N_MIXERS, i // N_MIXERS
        sh1p, sc1p, g1p, sh2p, sc2p, g2p = adaln(c_prompt, ada_w[i], ada_b[i])
        sh1s, sc1s, g1s, sh2s, sc2s, g2s = adaln(c_sample, ada_w[i], ada_b[i])
        hp = xp * (1 + sc1p) + sh1p
        hs = xs * (1 + sc1s) + sh1s
        if kind == 0:
            op, _ = gmlp_mixer(hp, gmlp_w_in[j], gmlp_ln_g[j], gmlp_ln_b[j], gmlp_w_s[j], gmlp_b_s[j], gmlp_w_out[j])
            os_, v_s = gmlp_mixer(hs, gmlp_w_in[j], gmlp_ln_g[j], gmlp_ln_b[j], gmlp_w_s[j], gmlp_b_s[j], gmlp_w_out[j])
            gmlp_v_rows.append(v_s)
        elif kind == 1:
            ctx0 = jnp.zeros((xp.shape[0], CONV_WIDTH - 1, D_MODEL), xp.dtype)
            op, st_p = conv_module(hp, ctx0, conv_w_pw1[j], conv_b_pw1[j], conv_w_dw[j], conv_b_dw[j],
                                   conv_ln_g[j], conv_ln_b[j], conv_w_pw2[j], conv_b_pw2[j])
            os_, st_s = conv_module(hs, state_conv[j], conv_w_pw1[j], conv_b_pw1[j], conv_w_dw[j], conv_b_dw[j],
                                    conv_ln_g[j], conv_ln_b[j], conv_w_pw2[j], conv_b_pw2[j])
            conv_p_states.append(st_p)
            conv_s_states.append(st_s)
        else:
            qa, qr, ckv, kr = mla_project(hp, pos_p, mla_w_down[j], mla_g_q[j], mla_g_kv[j], mla_w_uq[j], mla_w_uk[j])
            op = mla_out(mla_prompt_attend(qa, qr, ckv, kr), mla_w_uv[j], mla_w_o[j])
            ckv_p_rows.append(ckv)
            kr_p_rows.append(kr)
            qa, qr, ckv, kr = mla_project(hs, pos_s, mla_w_down[j], mla_g_q[j], mla_g_kv[j], mla_w_uq[j], mla_w_uk[j])
            ckv_past = cache_ckv[j, page_table].reshape(dec_b, past_len, MLA_KV_RANK)
            kr_past = cache_krope[j, page_table].reshape(dec_b, past_len, MLA_ROPE)
            os_ = mla_out(mla_sample_attend(qa, qr, ckv, kr, ckv_past, kr_past), mla_w_uv[j], mla_w_o[j])
            ckv_s_rows.append(ckv)
            kr_s_rows.append(kr)
        xp = layer_norm(ALPHA * xp + g1p * op, ln_mix_g[i], ln_mix_b[i])
        xs = layer_norm(ALPHA * xs + g1s * os_, ln_mix_g[i], ln_mix_b[i])
        fp = swiglu_ffn(xp * (1 + sc2p) + sh2p, ffn_w_gate[i], ffn_w_up[i], ffn_w_down[i])
        fs = swiglu_ffn(xs * (1 + sc2s) + sh2s, ffn_w_gate[i], ffn_w_up[i], ffn_w_down[i])
        xp = layer_norm(ALPHA * xp + g2p * fp, ln_ffn_g[i], ln_ffn_b[i])
        xs = layer_norm(ALPHA * xs + g2s * fs, ln_ffn_g[i], ln_ffn_b[i])
    return (xp, xs, jnp.stack(ckv_p_rows), jnp.stack(kr_p_rows), jnp.stack(ckv_s_rows), jnp.stack(kr_s_rows),
            jnp.stack(conv_p_states), jnp.stack(conv_s_states), jnp.stack(gmlp_v_rows))
```

```cpp
#include <hip/hip_runtime.h>
#include <cstdio>
#include <cstdint>
#include <cmath>
namespace pg8 {
#define PG8_LAS __attribute__((address_space(3)))
typedef unsigned short bf16_t;
typedef short bf16x8 __attribute__((ext_vector_type(8)));
typedef float f32x4 __attribute__((ext_vector_type(4)));
typedef unsigned u32x4 __attribute__((ext_vector_type(4)));
constexpr int BM = 256, BK = 64, HALF = 128, HTB = HALF * BK * 2  , STAGE_BYTES = 8 * HTB, NXCD = 8, WGM = 8;

__host__ __device__ __forceinline__ int lds_byte(int r, int c) { const int st = (r >> 4) * 2 + (c >> 5), rr = r & 15, cc = c & 31, ob = rr * 64 + cc * 2; return st * 1024 + (ob ^ (((ob >> 9) & 1) << 5)); }
__host__ __device__ __forceinline__ void stage_rc(int b, int& R, int& C) { const int st = b / 1024, sb = b % 1024, swz = sb ^ (((sb >> 9) & 1) << 5); R = (st >> 1) * 16 + swz / 64; C = (st & 1) * 32 + (swz % 64) / 2; }
__host__ __device__ __forceinline__ int perm32(int rho) { const int n = rho >> 4, i = rho & 15; return 8 * (i >> 2) + 4 * n + (i & 3); }

struct Unit { int pm, pn; };
struct Gemm { const bf16_t* A; const bf16_t* Bt; int M, N, K; };

struct StaticOrder {
    int nM, nN, nwg, G, c;
    __host__ __device__ void init(int M, int N, int G_, int c_) { nM = M / BM; nN = N / BM; nwg = nM * nN; G = G_; c = c_; }
    __host__ __device__ bool next(int i, Unit& u) const {
        const long L = (long)i * G + c; if (L >= nwg) return false;
        int wgid = (int)L; { const int q = nwg / NXCD, r = nwg % NXCD, xcd = wgid % NXCD, off = wgid / NXCD; wgid = (xcd < r ? xcd * (q + 1) : r * (q + 1) + (xcd - r) * q) + off; }
        const int nig = WGM * nN, gid = wgid / nig, fm = gid * WGM, gsz = (nM - fm) < WGM ? (nM - fm) : WGM;
        u.pm = fm + ((wgid % nig) % gsz); u.pn = (wgid % nig) / gsz; return true;
    }
    __device__ __forceinline__ void a_ready(const Unit&) const {}
    __device__ __forceinline__ void done(const Unit&) const {}
};

__device__ __forceinline__ unsigned cvt_pk_bf16(float lo, float hi) { unsigned r; asm volatile("v_cvt_pk_bf16_f32 %0, %1, %2" : "=v"(r) : "v"(lo), "v"(hi)); return r; }
typedef float f32x2 __attribute__((ext_vector_type(2)));
__device__ __forceinline__ f32x2 gelu_pk(f32x2 v) {
    const f32x2 av = __builtin_elementwise_abs(v), d = av * 0.2316418882f + 1.0f;
    f32x2 t; t.x = __builtin_amdgcn_rcpf(d.x); t.y = __builtin_amdgcn_rcpf(d.y);
    f32x2 q = t * 0.5307027145f + (-0.7265760135f); q = q * t + 0.7107068705f; q = q * t + (-0.142248368f); q = q * t + 0.127414796f; q = q * t;
    const f32x2 s = (v * v) * (-0.72134752044f);
    f32x2 e; e.x = __builtin_amdgcn_exp2f(s.x); e.y = __builtin_amdgcn_exp2f(s.y);
    const f32x2 m = v * (q * e), r = v - m;
    f32x2 o; o.x = v.x < 0.f ? m.x : r.x; o.y = v.y < 0.f ? m.y : r.y; return o;
}

constexpr int NP_ROWS = 16384, NS_ROWS = 1024, M_ROWS = NP_ROWS + NS_ROWS, NCOND = 132, DM = 1024;
constexpr float DN_ALPHA = 1.681792830507429f;
__device__ __forceinline__ int cond_of(int row) { return row < NP_ROWS ? (row >> 12) : 4 + ((row - NP_ROWS) >> 3); }
__device__ __forceinline__ int posidx_of(int row) { return row < NP_ROWS ? (row & 4095) : 4096 + ((row - NP_ROWS) & 7); }
__device__ __forceinline__ float silu_f(float g) { return g * __builtin_amdgcn_rcpf(1.0f + __builtin_amdgcn_exp2f(-1.4426950408889634f * g)); }
__device__ __forceinline__ float sigm_f(float g) { return __builtin_amdgcn_rcpf(1.0f + __builtin_amdgcn_exp2f(-1.4426950408889634f * g)); }


struct EpiGmlpIn {
    static constexpr bool PERM = true, AFTER_DRAIN = false;
    bf16_t* U; bf16_t* V; f32x2* stats;
    __device__ __forceinline__ void operator()(const f32x4 (&acc)[2][2][4][2], const Unit& u, int wr, int wc, int fr, int fq) const {
        const int row0 = u.pm * BM + wr * 64 + fr; const bool isv = u.pn >= 8;
        bf16_t* base = isv ? V : U; const int col0 = (isv ? (u.pn - 8) : u.pn) * BM + wc * 32 + 8 * fq;
#pragma unroll
        for (int ai = 0; ai < 2; ++ai)
#pragma unroll
            for (int m = 0; m < 4; ++m) { const int row = row0 + ai * HALF + m * 16; bf16_t* rowp = base + (size_t)row * 2048 + col0; float s = 0.f, ss = 0.f;
#pragma unroll
                for (int bj = 0; bj < 2; ++bj) { const f32x4 v0 = acc[ai][bj][m][0], v1 = acc[ai][bj][m][1];
                    const f32x2 a = gelu_pk((f32x2){v0[0], v0[1]}), b = gelu_pk((f32x2){v0[2], v0[3]}), c = gelu_pk((f32x2){v1[0], v1[1]}), d = gelu_pk((f32x2){v1[2], v1[3]});
                    s += ((a.x + a.y) + (b.x + b.y)) + ((c.x + c.y) + (d.x + d.y));
                    ss += ((a.x * a.x + a.y * a.y) + (b.x * b.x + b.y * b.y)) + ((c.x * c.x + c.y * c.y) + (d.x * d.x + d.y * d.y));
                    u32x4 w; w.x = cvt_pk_bf16(a.x, a.y); w.y = cvt_pk_bf16(b.x, b.y); w.z = cvt_pk_bf16(c.x, c.y); w.w = cvt_pk_bf16(d.x, d.y);
                    *(u32x4*)(rowp + bj * HALF) = w; }
                if (isv) { s += __shfl_xor(s, 16); s += __shfl_xor(s, 32); ss += __shfl_xor(ss, 16); ss += __shfl_xor(ss, 32);
                    if (fq == 0) stats[(size_t)row * 32 + (u.pn - 8) * 4 + wc] = (f32x2){s, ss}; } }
    }
};
struct EpiResid {
    static constexpr bool PERM = false, AFTER_DRAIN = false;
    const float* x; float* pre; const float* gate;
    const float* bias;
    __device__ __forceinline__ void operator()(const f32x4 (&acc)[2][2][4][2], const Unit& u, int wr, int wc, int fr, int fq) const {
        const int row0 = u.pm * BM + wr * 64 + fr, col0 = u.pn * BM + wc * 32 + 4 * fq;
        f32x4 bv[2][2];
#pragma unroll
        for (int bj = 0; bj < 2; ++bj)
#pragma unroll
            for (int n = 0; n < 2; ++n) bv[bj][n] = bias ? *(const f32x4*)(bias + col0 + bj * HALF + n * 16) : (f32x4){0.f, 0.f, 0.f, 0.f};
#pragma unroll
        for (int ai = 0; ai < 2; ++ai)
#pragma unroll
            for (int m = 0; m < 4; ++m) { const int row = row0 + ai * HALF + m * 16; const float* gp = gate + (size_t)cond_of(row) * 6144 + col0;
                const float* xp = x + (size_t)row * DM + col0; float* pp = pre + (size_t)row * DM + col0;
#pragma unroll
                for (int bj = 0; bj < 2; ++bj)
#pragma unroll
                    for (int n = 0; n < 2; ++n) { const int o = bj * HALF + n * 16; const f32x4 xv = *(const f32x4*)(xp + o), gv = *(const f32x4*)(gp + o);
                        *(f32x4*)(pp + o) = xv * DN_ALPHA + gv * (acc[ai][bj][m][n] + bv[bj][n]); } }
    }
};
struct EpiSwiglu {
    static constexpr bool PERM = true, AFTER_DRAIN = false;
    bf16_t* act;
    __device__ __forceinline__ void operator()(const f32x4 (&acc)[2][2][4][2], const Unit& u, int wr, int wc, int fr, int fq) const {
        const int row0 = u.pm * BM + wr * 64 + fr, col0 = u.pn * HALF + wc * 32 + 8 * fq;
#pragma unroll
        for (int ai = 0; ai < 2; ++ai)
#pragma unroll
            for (int m = 0; m < 4; ++m) { const int row = row0 + ai * HALF + m * 16; float o[8];
#pragma unroll
                for (int n = 0; n < 2; ++n)
#pragma unroll
                    for (int e = 0; e < 4; ++e) o[n * 4 + e] = silu_f(acc[ai][0][m][n][e]) * acc[ai][1][m][n][e];
                u32x4 w; w.x = cvt_pk_bf16(o[0], o[1]); w.y = cvt_pk_bf16(o[2], o[3]); w.z = cvt_pk_bf16(o[4], o[5]); w.w = cvt_pk_bf16(o[6], o[7]);
                *(u32x4*)(act + (size_t)row * 2816 + col0) = w; }
    }
};
struct EpiGlu {
    static constexpr bool PERM = true, AFTER_DRAIN = false;
    bf16_t* glu; const float* bias; float* st_p; float* st_s;
    __device__ __forceinline__ void operator()(const f32x4 (&acc)[2][2][4][2], const Unit& u, int wr, int wc, int fr, int fq) const {
        const int row0 = u.pm * BM + wr * 64 + fr, col0 = u.pn * HALF + wc * 32 + 8 * fq;
        f32x4 b0[2], b1[2];
#pragma unroll
        for (int n = 0; n < 2; ++n) { b0[n] = *(const f32x4*)(bias + col0 + 4 * n); b1[n] = *(const f32x4*)(bias + 1024 + col0 + 4 * n); }
#pragma unroll
        for (int ai = 0; ai < 2; ++ai)
#pragma unroll
            for (int m = 0; m < 4; ++m) { const int row = row0 + ai * HALF + m * 16; float o[8];
#pragma unroll
                for (int n = 0; n < 2; ++n)
#pragma unroll
                    for (int e = 0; e < 4; ++e) o[n * 4 + e] = (acc[ai][0][m][n][e] + b0[n][e]) * sigm_f(acc[ai][1][m][n][e] + b1[n][e]);
                u32x4 w; w.x = cvt_pk_bf16(o[0], o[1]); w.y = cvt_pk_bf16(o[2], o[3]); w.z = cvt_pk_bf16(o[4], o[5]); w.w = cvt_pk_bf16(o[6], o[7]);
                *(u32x4*)(glu + (size_t)row * DM + col0) = w;
                float* sp = nullptr;
                if (row < NP_ROWS) { const int t = row & 4095; if (t >= 4066) sp = st_p + ((size_t)(row >> 12) * 30 + (t - 4066)) * DM + col0; }
                else { const int s = row - NP_ROWS; sp = st_s + ((size_t)(s >> 3) * 30 + 22 + (s & 7)) * DM + col0; }
                if (sp) { *(f32x4*)sp = (f32x4){o[0], o[1], o[2], o[3]}; *(f32x4*)(sp + 4) = (f32x4){o[4], o[5], o[6], o[7]}; } }
    }
};
struct EpiF32 {
    static constexpr bool PERM = false, AFTER_DRAIN = false;
    float* C; int ldc;
    __device__ __forceinline__ void operator()(const f32x4 (&acc)[2][2][4][2], const Unit& u, int wr, int wc, int fr, int fq) const {
        const int row0 = u.pm * BM + wr * 64 + fr, col0 = u.pn * BM + wc * 32 + 4 * fq;
#pragma unroll
        for (int ai = 0; ai < 2; ++ai)
#pragma unroll
            for (int m = 0; m < 4; ++m) { float* rowp = C + (size_t)(row0 + ai * HALF + m * 16) * ldc + col0;
#pragma unroll
                for (int bj = 0; bj < 2; ++bj)
#pragma unroll
                    for (int n = 0; n < 2; ++n) *(f32x4*)(rowp + bj * HALF + n * 16) = acc[ai][bj][m][n]; }
    }
};
struct EpiQ {
    static constexpr bool PERM = true, AFTER_DRAIN = false;
    bf16_t* q; float qscale;
    __device__ __forceinline__ void operator()(const f32x4 (&acc)[2][2][4][2], const Unit& u, int wr, int wc, int fr, int fq) const {
        const int row0 = u.pm * BM + wr * 64 + fr, col0 = u.pn * BM + wc * 32 + 8 * fq;
#pragma unroll
        for (int ai = 0; ai < 2; ++ai)
#pragma unroll
            for (int m = 0; m < 4; ++m) { bf16_t* rowp = q + (size_t)(row0 + ai * HALF + m * 16) * 2560 + col0;
#pragma unroll
                for (int bj = 0; bj < 2; ++bj) { const f32x4 v0 = acc[ai][bj][m][0] * qscale, v1 = acc[ai][bj][m][1] * qscale;
                    u32x4 w; w.x = cvt_pk_bf16(v0[0], v0[1]); w.y = cvt_pk_bf16(v0[2], v0[3]); w.z = cvt_pk_bf16(v1[0], v1[1]); w.w = cvt_pk_bf16(v1[2], v1[3]);
                    *(u32x4*)(rowp + bj * HALF) = w; } }
    }
};
struct EpiAda {
    static constexpr bool PERM = false, AFTER_DRAIN = false;
    float* mod; const float* bias;
    __device__ __forceinline__ void operator()(const f32x4 (&acc)[2][2][4][2], const Unit& u, int wr, int wc, int fr, int fq) const {
        const int row0 = u.pm * BM + wr * 64 + fr, col0 = u.pn * BM + wc * 32 + 4 * fq;
#pragma unroll
        for (int ai = 0; ai < 2; ++ai)
#pragma unroll
            for (int m = 0; m < 4; ++m) { const int row = row0 + ai * HALF + m * 16; if (row < NCOND) {
#pragma unroll
                for (int bj = 0; bj < 2; ++bj)
#pragma unroll
                    for (int n = 0; n < 2; ++n) { const int col = col0 + bj * HALF + n * 16, l = col / 6144, c = col - l * 6144;
                        *(f32x4*)(mod + ((size_t)l * NCOND + row) * 6144 + c) = acc[ai][bj][m][n] + *(const f32x4*)(bias + col); } } }
    }
};
template <class Epi, class Sched, bool ALIGN_EPI = false, bool SP2 = false>
__device__ __forceinline__ void gemm_phase(PG8_LAS unsigned char* lds, const Gemm g, const Sched& S, const Epi& E) {
    const int tid = threadIdx.x, wid = __builtin_amdgcn_readfirstlane(tid >> 6), lane = tid & 63, wr = wid >> 2, wc = wid & 3, fr = lane & 15, fq = lane >> 4;
    const int K = g.K, nt = K / BK;
    unsigned voffA[2], voffB[2];
#pragma unroll
    for (int i = 0; i < 2; ++i) { int R, C; stage_rc(tid * 16 + i * 8192, R, C); const int Rb = Epi::PERM ? ((R & ~31) + perm32(R & 31)) : R;
        voffA[i] = (unsigned)(R * K + C) * 2u; voffB[i] = (unsigned)(Rb * K + C) * 2u; }
    const size_t kstep = (size_t)(BK * 2);
    const size_t hstep = (size_t)HALF * K * 2;
    const size_t tstep = 2 * hstep;
    const unsigned ldsw = (unsigned)wid * 1024u;
    const int aoff = lds_byte(wr * 64 + fr, fq * 8), boff = lds_byte(wc * 32 + fr, fq * 8);
#define PG8_SA(b, h) (((b) * 2 + (h)) * HTB)
#define PG8_SB(b, h) ((4 + (b) * 2 + (h)) * HTB)
#define PG8_STAGE(bufoff, gbase, voff) do { _Pragma("unroll") for (int _i = 0; _i < 2; ++_i) \
        __builtin_amdgcn_global_load_lds((const unsigned*)((const char*)(gbase) + (voff)[_i]), (PG8_LAS unsigned*)(lds + (bufoff) + ldsw + _i * 8192), 16, 0, 0); } while (0)
#define PG8_LDA(dst, b, h) do { _Pragma("unroll") for (int m = 0; m < 4; ++m) _Pragma("unroll") for (int k = 0; k < 2; ++k) dst[m][k] = *(const PG8_LAS bf16x8*)(lds + PG8_SA(b, h) + aoff + m * 2048 + k * 1024); } while (0)
#define PG8_LDB(dst, b, h) do { _Pragma("unroll") for (int n = 0; n < 2; ++n) _Pragma("unroll") for (int k = 0; k < 2; ++k) dst[n][k] = *(const PG8_LAS bf16x8*)(lds + PG8_SB(b, h) + boff + n * 2048 + k * 1024); } while (0)
#define PG8_MMA(ai, bj, At, Bt) do { __builtin_amdgcn_s_setprio(1); _Pragma("unroll") for (int m = 0; m < 4; ++m) _Pragma("unroll") for (int n = 0; n < 2; ++n) _Pragma("unroll") for (int k = 0; k < 2; ++k) \
        acc[ai][bj][m][n] = __builtin_amdgcn_mfma_f32_16x16x32_bf16(Bt[n][k], At[m][k], acc[ai][bj][m][n], 0, 0, 0); __builtin_amdgcn_s_setprio(0); } while (0)
#define PG8_WAIT_V(n) asm volatile("s_waitcnt vmcnt(" #n ")" ::: "memory")
#define PG8_WAIT_L(n) asm volatile("s_waitcnt lgkmcnt(" #n ")" ::: "memory")
#define PG8_BAR __builtin_amdgcn_s_barrier()
#define PG8_SCHED __builtin_amdgcn_sched_barrier(0)
    Unit cur, nxt; int ui = 0;
    if (!S.next(0, cur)) return;
    f32x4 acc[2][2][4][2];
#pragma unroll
    for (int a = 0; a < 2; ++a)
#pragma unroll
        for (int b = 0; b < 2; ++b)
#pragma unroll
            for (int m = 0; m < 4; ++m)
#pragma unroll
                for (int n = 0; n < 2; ++n) acc[a][b][m][n] = (f32x4){0.f, 0.f, 0.f, 0.f};
    bf16x8 At[4][2], B0[2][2], B1[2][2];
    const char* cA = (const char*)g.A + (size_t)cur.pm * tstep; const char* cB = (const char*)g.Bt + (size_t)cur.pn * tstep;
    S.a_ready(cur);
    if constexpr (SP2) {
        PG8_STAGE(PG8_SB(0, 0), cB, voffB); PG8_STAGE(PG8_SB(0, 1), cB + hstep, voffB); PG8_STAGE(PG8_SA(0, 0), cA, voffA); PG8_STAGE(PG8_SA(0, 1), cA + hstep, voffA);
        if (wr == 1) PG8_BAR;
        PG8_WAIT_V(2); PG8_BAR;
        PG8_STAGE(PG8_SB(1, 0), cB + kstep, voffB); PG8_STAGE(PG8_SA(1, 0), cA + kstep, voffA); PG8_STAGE(PG8_SB(1, 1), cB + hstep + kstep, voffB);
        PG8_WAIT_V(6); PG8_BAR;
    } else {
        PG8_STAGE(PG8_SB(0, 0), cB, voffB); PG8_STAGE(PG8_SA(0, 0), cA, voffA); PG8_STAGE(PG8_SB(0, 1), cB + hstep, voffB); PG8_STAGE(PG8_SA(0, 1), cA + hstep, voffA);
        if (wr == 1) PG8_BAR;
        PG8_WAIT_V(4); PG8_BAR;
        PG8_STAGE(PG8_SB(1, 0), cB + kstep, voffB); PG8_STAGE(PG8_SA(1, 0), cA + kstep, voffA); PG8_STAGE(PG8_SB(1, 1), cB + hstep + kstep, voffB);
        PG8_WAIT_V(6); PG8_BAR;
    }
    for (;;) {
        const bool has_next = S.next(ui + 1, nxt);
        const char* nA = has_next ? (const char*)g.A + (size_t)nxt.pm * tstep : cA; const char* nB = has_next ? (const char*)g.Bt + (size_t)nxt.pn * tstep : cB;
#pragma unroll 1
        for (int t = 0; t < nt; t += 2) {
            const bool last = (t == nt - 2);
            const char* a1 = cA + (size_t)(t + 1) * kstep;
            const char* a2 = last ? nA : cA + (size_t)(t + 2) * kstep; const char* b2 = last ? nB : cB + (size_t)(t + 2) * kstep;
            const char* a3 = a2 + kstep; const char* b3 = b2 + kstep;
            if (last && has_next) S.a_ready(nxt);
            if constexpr (SP2) {
            PG8_LDB(B0, 0, 0); PG8_LDB(B1, 0, 1); PG8_SCHED; PG8_LDA(At, 0, 0); PG8_STAGE(PG8_SA(1, 1), a1 + hstep, voffA);
            PG8_WAIT_V(8); PG8_WAIT_L(0); PG8_BAR; PG8_MMA(0, 0, At, B0); PG8_MMA(0, 1, At, B1); PG8_BAR; PG8_SCHED;
            PG8_LDA(At, 0, 1); PG8_STAGE(PG8_SB(0, 0), b2, voffB); PG8_STAGE(PG8_SB(0, 1), b2 + hstep, voffB); PG8_STAGE(PG8_SA(0, 0), a2, voffA);
            PG8_WAIT_V(8); PG8_WAIT_L(0); PG8_BAR; PG8_MMA(1, 0, At, B0); PG8_MMA(1, 1, At, B1); PG8_BAR; PG8_SCHED;
            PG8_LDB(B0, 1, 0); PG8_LDB(B1, 1, 1); PG8_SCHED; PG8_LDA(At, 1, 0); PG8_STAGE(PG8_SA(0, 1), a2 + hstep, voffA);
            PG8_WAIT_V(8); PG8_WAIT_L(0); PG8_BAR; PG8_MMA(0, 0, At, B0); PG8_MMA(0, 1, At, B1); PG8_BAR; PG8_SCHED;
            PG8_LDA(At, 1, 1); PG8_STAGE(PG8_SB(1, 0), b3, voffB); PG8_STAGE(PG8_SB(1, 1), b3 + hstep, voffB); PG8_STAGE(PG8_SA(1, 0), a3, voffA);
            PG8_WAIT_V(8); PG8_WAIT_L(0); PG8_BAR; PG8_MMA(1, 0, At, B0); PG8_MMA(1, 1, At, B1); PG8_BAR; PG8_SCHED;
            } else {
            PG8_LDB(B0, 0, 0); PG8_SCHED; PG8_LDA(At, 0, 0); PG8_STAGE(PG8_SA(1, 1), a1 + hstep, voffA);
            PG8_WAIT_L(8); PG8_BAR; PG8_WAIT_L(0); PG8_MMA(0, 0, At, B0); PG8_BAR; PG8_SCHED;
            PG8_LDB(B1, 0, 1); PG8_STAGE(PG8_SB(0, 0), b2, voffB);
            PG8_BAR; PG8_WAIT_L(0); PG8_MMA(0, 1, At, B1); PG8_BAR;
            PG8_LDA(At, 0, 1); PG8_STAGE(PG8_SA(0, 0), a2, voffA);
            PG8_BAR; PG8_WAIT_L(0); PG8_MMA(1, 0, At, B0); PG8_BAR; PG8_SCHED;
            PG8_STAGE(PG8_SB(0, 1), b2 + hstep, voffB);
            PG8_WAIT_V(6); PG8_BAR; PG8_MMA(1, 1, At, B1); PG8_BAR;
            PG8_LDB(B0, 1, 0); PG8_SCHED; PG8_LDA(At, 1, 0); PG8_STAGE(PG8_SA(0, 1), a2 + hstep, voffA);
            PG8_WAIT_L(8); PG8_BAR; PG8_WAIT_L(0); PG8_MMA(0, 0, At, B0); PG8_BAR; PG8_SCHED;
            PG8_LDB(B1, 1, 1); PG8_STAGE(PG8_SB(1, 0), b3, voffB);
            PG8_BAR; PG8_WAIT_L(0); PG8_MMA(0, 1, At, B1); PG8_BAR;
            PG8_LDA(At, 1, 1); PG8_STAGE(PG8_SA(1, 0), a3, voffA);
            PG8_BAR; PG8_WAIT_L(0); PG8_MMA(1, 0, At, B0); PG8_BAR; PG8_SCHED;
            PG8_STAGE(PG8_SB(1, 1), b3 + hstep, voffB);
            PG8_WAIT_V(6); PG8_BAR; PG8_MMA(1, 1, At, B1); PG8_BAR;
            }
        }
        if constexpr (ALIGN_EPI) { if (wr == 0) PG8_BAR; }
        if constexpr (!Epi::AFTER_DRAIN) { E(acc, cur, wr, wc, fr, fq); S.done(cur); }
        if (!has_next) break;
#pragma unroll
        for (int a = 0; a < 2; ++a)
#pragma unroll
            for (int b = 0; b < 2; ++b)
#pragma unroll
                for (int m = 0; m < 4; ++m)
#pragma unroll
                    for (int n = 0; n < 2; ++n) acc[a][b][m][n] = (f32x4){0.f, 0.f, 0.f, 0.f};
        cur = nxt; cA = nA; cB = nB; ++ui;
        if constexpr (ALIGN_EPI) { if (wr == 1) PG8_BAR; }
    }
    PG8_WAIT_V(0);
    if constexpr (!ALIGN_EPI) { if (wr == 0) PG8_BAR; }
    PG8_BAR;
    if constexpr (Epi::AFTER_DRAIN) { E.fused(acc, cur, wr, wc, fr, fq, lds, wid, lane); S.done(cur); }
#undef PG8_SA
#undef PG8_SB
#undef PG8_STAGE
#undef PG8_LDA
#undef PG8_LDB
#undef PG8_MMA
#undef PG8_WAIT_V
#undef PG8_WAIT_L
#undef PG8_BAR
#undef PG8_SCHED
}
}

using pg8::NP_ROWS; using pg8::NS_ROWS; using pg8::M_ROWS; using pg8::NCOND; using pg8::DM;
constexpr int NWAVES = 8, NTHR = 512;
constexpr int FF = 2816, GD = 2048, NLAYER = 4;
constexpr int NPH = 34;
#ifndef MK_N_LAUNCHES
#define MK_N_LAUNCHES 1
#endif
constexpr float LN_EPS = 1e-5f, RMS_EPS = 1e-6f;
constexpr float QSCALE = 0.07216878364870323f * 1.4426950408889634f;

constexpr size_t al256(size_t x) { return (x + 255) & ~(size_t)255; }
constexpr size_t WS_CTL = 0, CTL_ZERO_BYTES = 1u << 20;
constexpr size_t WS_WADA  = CTL_ZERO_BYTES;
constexpr size_t WS_WGU   = WS_WADA  + al256((size_t)24576 * 1024 * 2);
constexpr size_t SZ_WGU   = (size_t)5632 * 1024 * 2;
constexpr size_t WS_WDN   = WS_WGU   + 4 * SZ_WGU;
constexpr size_t SZ_WDN   = (size_t)1024 * 2816 * 2;
constexpr size_t WS_WIN   = WS_WDN   + 4 * SZ_WDN;
constexpr size_t SZ_WIN   = (size_t)4096 * 1024 * 2;
constexpr size_t WS_WOUT  = WS_WIN   + 2 * SZ_WIN;
constexpr size_t SZ_WOUT  = (size_t)1024 * 2048 * 2;
constexpr size_t WS_WPW1  = WS_WOUT  + 2 * SZ_WOUT;
constexpr size_t WS_WPW2  = WS_WPW1  + (size_t)2048 * 1024 * 2;
constexpr size_t WS_WDOWN = WS_WPW2  + (size_t)1024 * 1024 * 2;
constexpr size_t WS_WQC   = WS_WDOWN + (size_t)768 * 1024 * 2;
constexpr size_t WS_WVO   = WS_WQC   + (size_t)2560 * 384 * 2;
constexpr size_t WS_AADA  = WS_WVO   + (size_t)1024 * 2048 * 2;
constexpr size_t WS_MOD   = WS_AADA  + (size_t)256 * 1024 * 2;
constexpr size_t WS_ROPE  = WS_MOD   + al256((size_t)4 * 132 * 6144 * 4);
constexpr size_t WS_XRES  = WS_ROPE  + al256((size_t)4104 * 32 * 8);
constexpr size_t WS_PRE   = WS_XRES  + (size_t)M_ROWS * 1024 * 4;
constexpr size_t WS_HBUF  = WS_PRE   + (size_t)M_ROWS * 1024 * 4;
constexpr size_t WS_U     = WS_HBUF  + (size_t)M_ROWS * 1024 * 2;
constexpr size_t WS_V     = WS_U     + (size_t)M_ROWS * 2048 * 2;
constexpr size_t WS_STATS = WS_V     + (size_t)M_ROWS * 2048 * 2;
constexpr size_t WS_ACT   = WS_STATS + (size_t)M_ROWS * 32 * 8;
constexpr size_t WS_GLU   = WS_ACT   + (size_t)M_ROWS * 2816 * 2;
constexpr size_t WS_CONVO = WS_GLU   + (size_t)M_ROWS * 1024 * 2;
constexpr size_t WS_DPROJ = WS_CONVO + (size_t)M_ROWS * 1024 * 2;
constexpr size_t WS_QLAT  = WS_DPROJ + (size_t)M_ROWS * 768 * 4;
constexpr size_t WS_Q     = WS_QLAT  + (size_t)M_ROWS * 384 * 2;
constexpr size_t WS_KC    = WS_Q     + (size_t)M_ROWS * 2560 * 2;
constexpr size_t WS_CTX   = WS_KC    + (size_t)M_ROWS * 320 * 2;
constexpr size_t WS_PARTO = WS_CTX   + (size_t)M_ROWS * 2048 * 2;
constexpr size_t WS_PARTML= WS_PARTO + (size_t)128 * 2 * 64 * 256 * 4;
constexpr size_t WS_END   = WS_PARTML + (size_t)128 * 2 * 64 * 2 * 4;
constexpr int CW_TMO = 0, CW_BAR = 4096;

constexpr size_t O_Y = 0, O_CKV_P = (size_t)M_ROWS * 1024, O_KR_P = O_CKV_P + (size_t)NP_ROWS * 256, O_CKV_S = O_KR_P + (size_t)NP_ROWS * 64, O_KR_S = O_CKV_S + (size_t)NS_ROWS * 256,
                 O_CONV_P = O_KR_S + (size_t)NS_ROWS * 64, O_CONV_S = O_CONV_P + (size_t)4 * 30 * 1024, O_GV = O_CONV_S + (size_t)128 * 30 * 1024, O_END = O_GV + (size_t)2 * 128 * 8 * 2048;

constexpr int RING_BYTES = 131072, MISC_OFF = RING_BYTES + 320, LDS_BYTES = 147456;

#define GAS __attribute__((address_space(1)))
#define LAS __attribute__((address_space(3)))
typedef unsigned short bf16;
typedef unsigned v4u __attribute__((ext_vector_type(4)));
typedef unsigned v2u __attribute__((ext_vector_type(2)));
typedef float f32x4 __attribute__((ext_vector_type(4)));
typedef float f32x2 __attribute__((ext_vector_type(2)));
typedef short bf16x8 __attribute__((ext_vector_type(8)));
typedef short v4i16 __attribute__((ext_vector_type(4)));
typedef GAS unsigned gu32;
#define RLX_AGENT __ATOMIC_RELAXED, __HIP_MEMORY_SCOPE_AGENT
__device__ __forceinline__ unsigned pk2(float lo, float hi) { return pg8::cvt_pk_bf16(lo, hi); }
__device__ __forceinline__ float bflo(unsigned w) { return __uint_as_float(w << 16); }
__device__ __forceinline__ float bfhi(unsigned w) { return __uint_as_float(w & 0xffff0000u); }
__device__ __forceinline__ float ex2(float x) { return __builtin_amdgcn_exp2f(x); }
__device__ __forceinline__ f32x4 mfma16(bf16x8 a, bf16x8 b, f32x4 c) { return __builtin_amdgcn_mfma_f32_16x16x32_bf16(a, b, c, 0, 0, 0); }
__device__ __forceinline__ v4i16 lds_tr(const LAS unsigned char* p) { return __builtin_amdgcn_ds_read_tr16_b64_v4i16((LAS v4i16*)p); }
__device__ __forceinline__ float wave_sum(float v) {
#pragma unroll
    for (int o = 1; o < 64; o <<= 1) v += __shfl_xor(v, o);
    return v;
}

#define XB_TMO      128
#define XB_XCNT(j)  (256  + 64 * (j))
#define XB_XSUB(j)  (1280 + 64 * (j))
#define XB_XGEN(j)  (2304 + 64 * (j))
#define XB_TOP      3328
#define XB_TOPGEN   3392
#define XCD_BAR_WORDS 3456
#define XB_SPIN_CAP (1u << 18)

__device__ __forceinline__ unsigned xb_ld(unsigned* p)              { return __hip_atomic_load(p, __ATOMIC_RELAXED, __HIP_MEMORY_SCOPE_AGENT); }
__device__ __forceinline__ unsigned xb_add(unsigned* p, unsigned v) { return __hip_atomic_fetch_add(p, v, __ATOMIC_RELAXED, __HIP_MEMORY_SCOPE_AGENT); }
__device__ __forceinline__ unsigned xb_xcc_id() { return (unsigned)__builtin_amdgcn_s_getreg((3 << 11) | 20) & 0xFu; }
#define XB_SPIN(cond, bar) do { unsigned _sp = 0; while (cond) { __builtin_amdgcn_s_sleep(1); \
    if ((++_sp & 255u) == 0u) { if (xb_ld(&(bar)[XB_TMO])) break; if (_sp > XB_SPIN_CAP) { atomicAdd(&(bar)[XB_TMO], 1u); break; } } } } while (0)

struct XcdBarrier {
    unsigned* bar; unsigned x;
    volatile LAS unsigned* st;
};

__device__ __forceinline__ XcdBarrier xcd_barrier_post(unsigned* bar, volatile LAS unsigned* st) {
    XcdBarrier b; b.bar = bar; b.x = xb_xcc_id(); b.st = st;
    if (threadIdx.x == 0) (void)xb_add(&bar[XB_XCNT(b.x)], 1u);
    return b;
}
__device__ __forceinline__ void xcd_barrier_complete(unsigned* bar, unsigned x, unsigned& nloc, unsigned& nx) {
    const unsigned G = gridDim.x * gridDim.y * gridDim.z;
    unsigned sum, cnt, mine, sp = 0u;
    for (;;) {
        sum = 0u; cnt = 0u; mine = 0u;
#pragma unroll
        for (unsigned j = 0; j < 16; ++j) { const unsigned c = xb_ld(&bar[XB_XCNT(j)]); sum += c; cnt += (c > 0u) ? 1u : 0u; mine = (j == x) ? c : mine; }
        if (sum == G) break;
        __builtin_amdgcn_s_sleep(1);
        if ((++sp & 255u) == 0u) { if (xb_ld(&bar[XB_TMO])) break; if (sp > XB_SPIN_CAP) { atomicAdd(&bar[XB_TMO], 1u); break; } }
    }
    nloc = mine > 0u ? mine : 1u; nx = cnt > 0u ? cnt : 1u;
}

__device__ __forceinline__ void xcd_barrier(const XcdBarrier& b) {
    asm volatile("s_waitcnt vmcnt(0)" ::: "memory");
    __syncthreads();
    if (threadIdx.x == 0) {
        unsigned* bar = b.bar;
        __builtin_amdgcn_s_waitcnt(0);
        unsigned nloc = b.st[0], nx = b.st[1];
        if (nloc == 0u) { xcd_barrier_complete(bar, b.x, nloc, nx); b.st[0] = nloc; b.st[1] = nx; }
        const unsigned old = xb_add(&bar[XB_XSUB(b.x)], 1u);
        const unsigned gen = old / nloc;
        if (old + 1u == (gen + 1u) * nloc) {
            __builtin_amdgcn_fence(__ATOMIC_RELEASE, "agent");
            asm volatile("s_waitcnt vmcnt(0)" ::: "memory");
            const unsigned og = xb_add(&bar[XB_TOP], 1u);
            const unsigned tg = og / nx;
            if (og + 1u == (tg + 1u) * nx) xb_add(&bar[XB_TOPGEN], 1u);
            else XB_SPIN(xb_ld(&bar[XB_TOPGEN]) == tg, bar);
            __builtin_amdgcn_fence(__ATOMIC_ACQUIRE, "agent");
            xb_add(&bar[XB_XGEN(b.x)], 1u);
            asm volatile("s_waitcnt vmcnt(0)" ::: "memory");
        } else {
            XB_SPIN(xb_ld(&bar[XB_XGEN(b.x)]) == gen, bar);
            __builtin_amdgcn_fence(__ATOMIC_ACQUIRE, "agent");
            asm volatile("s_waitcnt vmcnt(0)" ::: "memory");
        }
    }
    __syncthreads();
}

struct Frame {
    LAS unsigned char* lds;
    int tid, lane, wave, G;
    float* out; unsigned char* ws;
};
struct Args { const float* in[38]; float* out; unsigned char* ws; int ph_lo, ph_hi, li, pad; };
#define WSP(T, off) ((T*)(F.ws + (off)))

__device__ __forceinline__ void tr_item(const float* W, int ldw, int coff, int K, int Ncols, bf16* WT, int mode, int hf, int roff, int item, int lane, LAS float* scr) {
    const int nblk = Ncols / 32, kb = item / nblk, nb = item % nblk, k0 = 64 * kb, n0 = 32 * nb;
#pragma unroll 8
    for (int i = 0; i < 32; ++i) { const int kk = 2 * i + (lane >> 5); scr[kk * 33 + (lane & 31)] = W[(size_t)(k0 + kk) * ldw + coff + n0 + (lane & 31)]; }
    asm volatile("s_waitcnt lgkmcnt(0)" ::: "memory");
    const int c = lane & 7;
#pragma unroll
    for (int j = 0; j < 4; ++j) { const int n = (lane >> 3) + 8 * j; const LAS float* s = scr + (8 * c) * 33 + n; const int ng = n0 + n;
        const int drow = roff + (mode ? (256 * (ng >> 7) + 128 * hf + (ng & 127)) : ng);
        v4u o; o.x = pk2(s[0 * 33], s[1 * 33]); o.y = pk2(s[2 * 33], s[3 * 33]); o.z = pk2(s[4 * 33], s[5 * 33]); o.w = pk2(s[6 * 33], s[7 * 33]);
        *(v4u*)(WT + (size_t)drow * K + k0 + 8 * c) = o; }
    asm volatile("s_waitcnt lgkmcnt(0)" ::: "memory");
}
__device__ __forceinline__ void p0_prologue(Frame& F, const Args& A) {
    LAS float* scr = (LAS float*)(F.lds + F.wave * 16384);
    const int gw = blockIdx.x * NWAVES + F.wave, NGW = F.G * NWAVES;
    constexpr int I_ADA = 16 * 192, I_GU = 16 * 88, I_DN = 44 * 32, I_IN = 16 * 128, I_OUT = 32 * 32, I_PW1 = 16 * 32, I_PW2 = 16 * 32, I_DOWN = 16 * 22;
    constexpr int NITEMS = 4 * I_ADA + 4 * (2 * I_GU + I_DN) + 2 * (I_IN + I_OUT) + 2 * I_PW1 + I_PW2 + I_DOWN;
    for (int it = gw; it < NITEMS; it += NGW) {
        int r = it; bool done = false;
#pragma unroll
        for (int l = 0; l < 4; ++l) { if (!done && r < I_ADA) { tr_item(A.in[8] + (size_t)l * 1024 * 6144, 6144, 0, 1024, 6144, WSP(bf16, WS_WADA), 0, 0, l * 6144, r, F.lane, scr); done = true; } r -= I_ADA; }
#pragma unroll
        for (int l = 0; l < 4; ++l) {
            if (!done && r >= 0 && r < I_GU) { tr_item(A.in[14] + (size_t)l * 1024 * FF, FF, 0, 1024, FF, WSP(bf16, WS_WGU + l * SZ_WGU), 1, 0, 0, r, F.lane, scr); done = true; } r -= I_GU;
            if (!done && r >= 0 && r < I_GU) { tr_item(A.in[15] + (size_t)l * 1024 * FF, FF, 0, 1024, FF, WSP(bf16, WS_WGU + l * SZ_WGU), 1, 1, 0, r, F.lane, scr); done = true; } r -= I_GU;
            if (!done && r >= 0 && r < I_DN) { tr_item(A.in[16] + (size_t)l * FF * 1024, 1024, 0, FF, 1024, WSP(bf16, WS_WDN + l * SZ_WDN), 0, 0, 0, r, F.lane, scr); done = true; } r -= I_DN; }
#pragma unroll
        for (int j = 0; j < 2; ++j) {
            if (!done && r >= 0 && r < I_IN) { tr_item(A.in[17] + (size_t)j * 1024 * 4096, 4096, 0, 1024, 4096, WSP(bf16, WS_WIN + j * SZ_WIN), 0, 0, 0, r, F.lane, scr); done = true; } r -= I_IN;
            if (!done && r >= 0 && r < I_OUT) { tr_item(A.in[22] + (size_t)j * 2048 * 1024, 1024, 0, 2048, 1024, WSP(bf16, WS_WOUT + j * SZ_WOUT), 0, 0, 0, r, F.lane, scr); done = true; } r -= I_OUT; }
        if (!done && r >= 0 && r < I_PW1) { tr_item(A.in[23], 2048, 0, 1024, 1024, WSP(bf16, WS_WPW1), 1, 0, 0, r, F.lane, scr); done = true; } r -= I_PW1;
        if (!done && r >= 0 && r < I_PW1) { tr_item(A.in[23], 2048, 1024, 1024, 1024, WSP(bf16, WS_WPW1), 1, 1, 0, r, F.lane, scr); done = true; } r -= I_PW1;
        if (!done && r >= 0 && r < I_PW2) { tr_item(A.in[29], 1024, 0, 1024, 1024, WSP(bf16, WS_WPW2), 0, 0, 0, r, F.lane, scr); done = true; } r -= I_PW2;
        if (!done && r >= 0 && r < I_DOWN) { tr_item(A.in[31], 704, 0, 1024, 704, WSP(bf16, WS_WDOWN), 0, 0, 0, r, F.lane, scr); done = true; }
    }
    const size_t gt = (size_t)blockIdx.x * NTHR + F.tid, NGT = (size_t)F.G * NTHR;
    for (size_t i = gt; i < (size_t)64 * 1024 / 8; i += NGT) *(v4u*)(WSP(bf16, WS_WDOWN) + (size_t)704 * 1024 + i * 8) = (v4u){0u, 0u, 0u, 0u};
    for (size_t i = gt; i < (size_t)256 * 1024 / 4; i += NGT) { const int r = (int)(i >> 8), c4 = (int)(i & 255) * 4; v2u o = (v2u){0u, 0u};
        if (r < NCOND) { const f32x4 v = r < 4 ? *(const f32x4*)(A.in[6] + (size_t)r * 1024 + c4) : *(const f32x4*)(A.in[7] + (size_t)(r - 4) * 1024 + c4);
            o.x = pk2(pg8::silu_f(v[0]), pg8::silu_f(v[1])); o.y = pk2(pg8::silu_f(v[2]), pg8::silu_f(v[3])); }
        *(v2u*)(WSP(bf16, WS_AADA) + (size_t)r * 1024 + c4) = o; }
    for (size_t i = gt; i < (size_t)4104 * 32; i += NGT) { const int pi = (int)(i >> 5), d = (int)(i & 31); const double pos = pi < 4096 ? (double)pi : (double)(8192 + pi - 4096);
        const double inv = exp2(-(double)d * (13.287712379549449 / 32.0)); const double ang = pos * inv; double sn, cs; sincos(ang, &sn, &cs);
        WSP(f32x2, WS_ROPE)[i] = (f32x2){(float)cs, (float)sn}; }
    for (size_t i = gt; i < (size_t)2560 * 384; i += NGT) { const int n = (int)(i / 384), r = (int)(i % 384); float acc = 0.f;
        if (n < 2048) { const int h = n >> 8, c = n & 255; const f32x4* a = (const f32x4*)(A.in[34] + (size_t)r * 1536 + h * 192); const f32x4* b = (const f32x4*)(A.in[35] + ((size_t)c * 8 + h) * 128);
#pragma unroll 8
            for (int k = 0; k < 32; ++k) { const f32x4 x = a[k], y = b[k]; acc += (x[0] * y[0] + x[1] * y[1]) + (x[2] * y[2] + x[3] * y[3]); } }
        else { acc = A.in[34][(size_t)r * 1536 + ((n - 2048) >> 6) * 192 + 128 + ((n - 2048) & 63)]; }
        WSP(bf16, WS_WQC)[i] = (bf16)(pk2(acc, 0.f) & 0xffffu); }
    for (size_t i = gt; i < (size_t)2048 * 1024; i += NGT) { const int k = (int)(i >> 10), d = (int)(i & 1023), h = k >> 8, c = k & 255; float acc = 0.f;
        const float* a = A.in[36] + ((size_t)c * 8 + h) * 128; const float* b = A.in[37] + (size_t)h * 128 * 1024 + d;
#pragma unroll 8
        for (int v = 0; v < 128; ++v) acc += a[v] * b[(size_t)v * 1024];
        WSP(bf16, WS_WVO)[(size_t)d * 2048 + k] = (bf16)(pk2(acc, 0.f) & 0xffffu); }
    for (size_t i = gt; i < (size_t)128 * 22 * 256; i += NGT) { const int b = (int)(i / (22 * 256)), rem = (int)(i % (22 * 256));
        *(f32x4*)(F.out + O_CONV_S + (size_t)b * 30 * 1024 + (size_t)rem * 4) = *(const f32x4*)(A.in[4] + ((size_t)b * 30 + 8) * 1024 + (size_t)rem * 4); }
}

__device__ __forceinline__ const float* xrow_in(Frame& F, const Args& A, int row) { return row < NP_ROWS ? A.in[0] + (size_t)row * 1024 : A.in[1] + (size_t)(row - NP_ROWS) * 1024; }
__device__ __forceinline__ void p2_first_h(Frame& F, const Args& A) {
    const int gw = blockIdx.x * NWAVES + F.wave, NGW = F.G * NWAVES;
    const float* mod = WSP(const float, WS_MOD);
    for (int row = gw; row < M_ROWS; row += NGW) { const float* xr = xrow_in(F, A, row); const float* mp = mod + (size_t)pg8::cond_of(row) * 6144;
#pragma unroll
        for (int j = 0; j < 4; ++j) { const int c = 4 * F.lane + 256 * j; const f32x4 v = *(const f32x4*)(xr + c), sh = *(const f32x4*)(mp + c), sc = *(const f32x4*)(mp + 1024 + c);
            *(f32x4*)(WSP(float, WS_XRES) + (size_t)row * 1024 + c) = v; const f32x4 h = v * (sc + 1.0f) + sh;
            *(v2u*)(WSP(bf16, WS_HBUF) + (size_t)row * 1024 + c) = (v2u){pk2(h[0], h[1]), pk2(h[2], h[3])}; } }
}
__device__ __forceinline__ void ln_phase(Frame& F, const float* g, const float* b, float* xout, const float* modp) {
    const int gw = blockIdx.x * NWAVES + F.wave, NGW = F.G * NWAVES;
    const float* pre = WSP(const float, WS_PRE);
    for (int row = gw; row < M_ROWS; row += NGW) { f32x4 v[4]; float s = 0.f;
#pragma unroll
        for (int j = 0; j < 4; ++j) { v[j] = *(const f32x4*)(pre + (size_t)row * 1024 + 4 * F.lane + 256 * j); s += (v[j][0] + v[j][1]) + (v[j][2] + v[j][3]); }
        const float mean = wave_sum(s) * (1.f / 1024.f); float s2 = 0.f;
#pragma unroll
        for (int j = 0; j < 4; ++j) { v[j] = v[j] - mean; s2 += (v[j][0] * v[j][0] + v[j][1] * v[j][1]) + (v[j][2] * v[j][2] + v[j][3] * v[j][3]); }
        const float rstd = 1.0f / sqrtf(wave_sum(s2) * (1.f / 1024.f) + LN_EPS);
        const float* mp = modp ? modp + (size_t)pg8::cond_of(row) * 6144 : nullptr;
#pragma unroll
        for (int j = 0; j < 4; ++j) { const int c = 4 * F.lane + 256 * j; const f32x4 x = v[j] * rstd * *(const f32x4*)(g + c) + *(const f32x4*)(b + c);
            *(f32x4*)(xout + (size_t)row * 1024 + c) = x;
            if (mp) { const f32x4 h = x * (*(const f32x4*)(mp + 1024 + c) + 1.0f) + *(const f32x4*)(mp + c);
                *(v2u*)(WSP(bf16, WS_HBUF) + (size_t)row * 1024 + c) = (v2u){pk2(h[0], h[1]), pk2(h[2], h[3])}; } } }
}

constexpr int VSTR = 544, WSTR = 272, SP_V = 0, SP_W = 128 * VSTR, SP_ST = SP_W + 128 * WSTR;
__device__ __forceinline__ void spatial_phase(Frame& F, const Args& A, int j) {
    const float* lng = A.in[18] + (size_t)j * GD; const float* lnb = A.in[19] + (size_t)j * GD; const float* ws = A.in[20] + (size_t)j * 8 * 128 * 128; const float* bs = A.in[21] + (size_t)j * 8 * 128;
    bf16* U = WSP(bf16, WS_U); const bf16* V = WSP(const bf16, WS_V); const f32x2* stats = WSP(const f32x2, WS_STATS);
    float* gv_out = F.out + O_GV + (size_t)j * 1024 * 2048;
    const int fr = F.lane & 15, fq = F.lane >> 4;
    LAS f32x2* rst = (LAS f32x2*)(F.lds + SP_ST);
    for (int u = blockIdx.x; u < 136 * 8; u += F.G) { const int chunk = u >> 3, g = u & 7, row0 = chunk * 128; const bool smp = chunk >= 128;
        if (F.tid < 128) { const f32x2* sp = stats + (size_t)(row0 + F.tid) * 32; float s = 0.f, ss = 0.f;
#pragma unroll 8
            for (int k = 0; k < 32; ++k) { const f32x2 p = sp[k]; s += p.x; ss += p.y; }
            const float mean = s * (1.f / 2048.f), var = fmaxf(ss * (1.f / 2048.f) - mean * mean, 0.f); rst[F.tid] = (f32x2){mean, 1.0f / sqrtf(var + LN_EPS)}; }
#pragma unroll
        for (int i = 0; i < 4; ++i) { const int cid = F.tid + 512 * i, t = cid >> 4, s0 = (cid & 15) * 8; float w[8];
            if (!smp) { const f32x4 a = *(const f32x4*)(ws + ((size_t)g * 128 + t) * 128 + s0), b = *(const f32x4*)(ws + ((size_t)g * 128 + t) * 128 + s0 + 4);
#pragma unroll
                for (int e = 0; e < 4; ++e) { w[e] = (s0 + e <= t) ? a[e] : 0.f; w[4 + e] = (s0 + 4 + e <= t) ? b[e] : 0.f; } }
            else { const int tt = t & 7; const bool blk = (t >> 3) == (s0 >> 3); const f32x4 a = *(const f32x4*)(ws + ((size_t)g * 128 + tt) * 128), b = *(const f32x4*)(ws + ((size_t)g * 128 + tt) * 128 + 4);
#pragma unroll
                for (int e = 0; e < 4; ++e) { w[e] = (blk && e <= tt) ? a[e] : 0.f; w[4 + e] = (blk && 4 + e <= tt) ? b[e] : 0.f; } }
            *(LAS v4u*)(F.lds + SP_W + t * WSTR + s0 * 2) = (v4u){pk2(w[0], w[1]), pk2(w[2], w[3]), pk2(w[4], w[5]), pk2(w[6], w[7])}; }
        __syncthreads();
#pragma unroll
        for (int i = 0; i < 8; ++i) { const int cid = F.tid + 512 * i, r = cid >> 5, c8 = (cid & 31) * 8; const int col = g * 256 + c8;
            const v4u raw = *(const v4u*)(V + (size_t)(row0 + r) * 2048 + col); const f32x2 st = rst[r];
            const f32x4 g0 = *(const f32x4*)(lng + col), g1 = *(const f32x4*)(lng + col + 4), b0 = *(const f32x4*)(lnb + col), b1 = *(const f32x4*)(lnb + col + 4);
            float x[8] = {bflo(raw.x), bfhi(raw.x), bflo(raw.y), bfhi(raw.y), bflo(raw.z), bfhi(raw.z), bflo(raw.w), bfhi(raw.w)};
#pragma unroll
            for (int e = 0; e < 4; ++e) { x[e] = (x[e] - st.x) * st.y * g0[e] + b0[e]; x[4 + e] = (x[4 + e] - st.x) * st.y * g1[e] + b1[e]; }
            *(LAS v4u*)(F.lds + SP_V + r * VSTR + c8 * 2) = (v4u){pk2(x[0], x[1]), pk2(x[2], x[3]), pk2(x[4], x[5]), pk2(x[6], x[7])};
            if (smp) { float* op = gv_out + (size_t)(row0 - NP_ROWS + r) * 2048 + col; *(f32x4*)op = (f32x4){x[0], x[1], x[2], x[3]}; *(f32x4*)(op + 4) = (f32x4){x[4], x[5], x[6], x[7]}; } }
        __syncthreads();
        bf16x8 af[2][4];
#pragma unroll
        for (int ct = 0; ct < 2; ++ct)
#pragma unroll
            for (int ks = 0; ks < 4; ++ks) { const LAS unsigned char* p0 = F.lds + SP_V + (32 * ks + 8 * fq + (fr >> 2)) * VSTR + (32 * F.wave + 16 * ct) * 2 + 8 * (fr & 3);
                const v4i16 lo = lds_tr(p0), hi = lds_tr(p0 + 4 * VSTR); af[ct][ks] = (bf16x8){lo[0], lo[1], lo[2], lo[3], hi[0], hi[1], hi[2], hi[3]}; }
#pragma unroll
        for (int tt = 0; tt < 8; ++tt) { f32x4 acc[2] = {(f32x4){0.f, 0.f, 0.f, 0.f}, (f32x4){0.f, 0.f, 0.f, 0.f}};
#pragma unroll
            for (int ks = 0; ks <= (tt >> 1); ++ks) { const bf16x8 bfr = *(const LAS bf16x8*)(F.lds + SP_W + (16 * tt + fr) * WSTR + (32 * ks + 8 * fq) * 2);
                acc[0] = mfma16(af[0][ks], bfr, acc[0]); acc[1] = mfma16(af[1][ks], bfr, acc[1]); }
            const int t = 16 * tt + fr; const float bias = bs[g * 128 + (smp ? (t & 7) : t)];
#pragma unroll
            for (int ct = 0; ct < 2; ++ct) { bf16* up = U + (size_t)(row0 + t) * 2048 + g * 256 + 32 * F.wave + 16 * ct + 4 * fq; const v2u uu = *(const v2u*)up;
                *(v2u*)up = (v2u){pk2(bflo(uu.x) * (acc[ct][0] + bias), bfhi(uu.x) * (acc[ct][1] + bias)), pk2(bflo(uu.y) * (acc[ct][2] + bias), bfhi(uu.y) * (acc[ct][3] + bias))}; } }
        __syncthreads();
    }
}

__device__ __forceinline__ void dwconv_phase(Frame& F, const Args& A) {
    const int gw = blockIdx.x * NWAVES + F.wave, NGW = F.G * NWAVES;
    const bf16* glu = WSP(const bf16, WS_GLU); bf16* co = WSP(bf16, WS_CONVO);
    const float* wdw = A.in[25]; const float* bdw = A.in[26]; const float* lg = A.in[27]; const float* lb = A.in[28]; const float* stc = A.in[4];
    const int c0 = 16 * F.lane;
    for (int row = gw; row < M_ROWS; row += NGW) { float y[16];
#pragma unroll
        for (int e = 0; e < 16; e += 4) { const f32x4 bb = *(const f32x4*)(bdw + c0 + e); y[e] = bb[0]; y[e + 1] = bb[1]; y[e + 2] = bb[2]; y[e + 3] = bb[3]; }
        const bool smp = row >= NP_ROWS; const int t = smp ? ((row - NP_ROWS) & 7) : (row & 4095); const int sb = smp ? ((row - NP_ROWS) >> 3) : 0;
        for (int k = 0; k < 31; ++k) { float x[16]; bool have = true;
            if (!smp) { const int tp = t - 30 + k; if (tp < 0) have = false; else { const v4u a = *(const v4u*)(glu + (size_t)(row - 30 + k) * 1024 + c0), b = *(const v4u*)(glu + (size_t)(row - 30 + k) * 1024 + c0 + 8);
                    x[0] = bflo(a.x); x[1] = bfhi(a.x); x[2] = bflo(a.y); x[3] = bfhi(a.y); x[4] = bflo(a.z); x[5] = bfhi(a.z); x[6] = bflo(a.w); x[7] = bfhi(a.w);
                    x[8] = bflo(b.x); x[9] = bfhi(b.x); x[10] = bflo(b.y); x[11] = bfhi(b.y); x[12] = bflo(b.z); x[13] = bfhi(b.z); x[14] = bflo(b.w); x[15] = bfhi(b.w); } }
            else { const int idx = t + k; if (idx < 30) { const float* sp = stc + ((size_t)sb * 30 + idx) * 1024 + c0;
#pragma unroll
                    for (int e = 0; e < 16; e += 4) { const f32x4 q = *(const f32x4*)(sp + e); x[e] = q[0]; x[e + 1] = q[1]; x[e + 2] = q[2]; x[e + 3] = q[3]; } }
                else { const size_t gr = (size_t)NP_ROWS + sb * 8 + (idx - 30); const v4u a = *(const v4u*)(glu + gr * 1024 + c0), b = *(const v4u*)(glu + gr * 1024 + c0 + 8);
                    x[0] = bflo(a.x); x[1] = bfhi(a.x); x[2] = bflo(a.y); x[3] = bfhi(a.y); x[4] = bflo(a.z); x[5] = bfhi(a.z); x[6] = bflo(a.w); x[7] = bfhi(a.w);
                    x[8] = bflo(b.x); x[9] = bfhi(b.x); x[10] = bflo(b.y); x[11] = bfhi(b.y); x[12] = bflo(b.z); x[13] = bfhi(b.z); x[14] = bflo(b.w); x[15] = bfhi(b.w); } }
            if (have) {
#pragma unroll
                for (int e = 0; e < 16; e += 4) { const f32x4 w = *(const f32x4*)(wdw + (size_t)k * 1024 + c0 + e); y[e] += w[0] * x[e]; y[e + 1] += w[1] * x[e + 1]; y[e + 2] += w[2] * x[e + 2]; y[e + 3] += w[3] * x[e + 3]; } } }
        float s = 0.f;
#pragma unroll
        for (int e = 0; e < 16; ++e) s += y[e];
        const float mean = wave_sum(s) * (1.f / 1024.f); float s2 = 0.f;
#pragma unroll
        for (int e = 0; e < 16; ++e) { y[e] -= mean; s2 += y[e] * y[e]; }
        const float rstd = 1.0f / sqrtf(wave_sum(s2) * (1.f / 1024.f) + LN_EPS);
        unsigned o[8];
#pragma unroll
        for (int e = 0; e < 16; e += 2) { const float a = pg8::silu_f(y[e] * rstd * lg[c0 + e] + lb[c0 + e]), b = pg8::silu_f(y[e + 1] * rstd * lg[c0 + e + 1] + lb[c0 + e + 1]); o[e >> 1] = pk2(a, b); }
        *(v4u*)(co + (size_t)row * 1024 + c0) = (v4u){o[0], o[1], o[2], o[3]}; *(v4u*)(co + (size_t)row * 1024 + c0 + 8) = (v4u){o[4], o[5], o[6], o[7]}; }
}

__device__ __forceinline__ void mla_post_phase(Frame& F, const Args& A) {
    const int gw = blockIdx.x * NWAVES + F.wave, NGW = F.G * NWAVES;
    const float* dp = WSP(const float, WS_DPROJ); const float* gq = A.in[32]; const float* gkv = A.in[33]; const f32x2* rope = WSP(const f32x2, WS_ROPE);
    bf16* qlat = WSP(bf16, WS_QLAT); bf16* kc = WSP(bf16, WS_KC);
    for (int row = gw; row < M_ROWS; row += NGW) { const float* d = dp + (size_t)row * 768;
        float q[6]; float s = 0.f;
#pragma unroll
        for (int i = 0; i < 6; ++i) { q[i] = d[F.lane + 64 * i]; s += q[i] * q[i]; }
        const float rq = 1.0f / sqrtf(wave_sum(s) * (1.f / 384.f) + RMS_EPS);
#pragma unroll
        for (int i = 0; i < 6; ++i) qlat[(size_t)row * 384 + F.lane + 64 * i] = (bf16)(pk2(q[i] * rq * gq[F.lane + 64 * i], 0.f) & 0xffffu);
        const f32x4 c = *(const f32x4*)(d + 384 + 4 * F.lane); const float s2 = (c[0] * c[0] + c[1] * c[1]) + (c[2] * c[2] + c[3] * c[3]);
        const float rk = 1.0f / sqrtf(wave_sum(s2) * (1.f / 256.f) + RMS_EPS);
        const f32x4 ck = c * rk * *(const f32x4*)(gkv + 4 * F.lane);
        float* ockv = row < NP_ROWS ? F.out + O_CKV_P + (size_t)row * 256 : F.out + O_CKV_S + (size_t)(row - NP_ROWS) * 256;
        *(f32x4*)(ockv + 4 * F.lane) = ck; *(v2u*)(kc + (size_t)row * 320 + 4 * F.lane) = (v2u){pk2(ck[0], ck[1]), pk2(ck[2], ck[3])};
        if (F.lane < 32) { const float x1 = d[640 + F.lane], x2 = d[672 + F.lane]; const f32x2 cs = rope[(size_t)pg8::posidx_of(row) * 32 + F.lane];
            const float o1 = x1 * cs.x - x2 * cs.y, o2 = x2 * cs.x + x1 * cs.y;
            float* okr = row < NP_ROWS ? F.out + O_KR_P + (size_t)row * 64 : F.out + O_KR_S + (size_t)(row - NP_ROWS) * 64;
            okr[F.lane] = o1; okr[32 + F.lane] = o2;
            kc[(size_t)row * 320 + 256 + F.lane] = (bf16)(pk2(o1, 0.f) & 0xffffu); kc[(size_t)row * 320 + 288 + F.lane] = (bf16)(pk2(o2, 0.f) & 0xffffu); } }
}

constexpr int KSTR = 656, KIMG = 64 * KSTR;
template <int NKT>
__device__ __forceinline__ void attn_core(const LAS unsigned char* imgw, const bf16x8 (&qf)[10], f32x4 (&o)[16], float& m, float& l, int fr, int fq, bool domask, int key0, int limit) {
    f32x4 s[NKT];
#pragma unroll
    for (int kt = 0; kt < NKT; ++kt) { s[kt] = (f32x4){0.f, 0.f, 0.f, 0.f}; bf16x8 kf[10];
#pragma unroll
        for (int ks = 0; ks < 10; ++ks) kf[ks] = *(const LAS bf16x8*)(imgw + (16 * kt + fr) * KSTR + ks * 64 + fq * 16);
#pragma unroll
        for (int ks = 0; ks < 10; ++ks) s[kt] = mfma16(kf[ks], qf[ks], s[kt]);
        __builtin_amdgcn_sched_barrier(0); }
    if (domask) {
#pragma unroll
        for (int kt = 0; kt < NKT; ++kt)
#pragma unroll
            for (int i = 0; i < 4; ++i) if (key0 + 16 * kt + 4 * fq + i > limit) s[kt][i] = -1e30f; }
    float mx = s[0][0];
#pragma unroll
    for (int kt = 0; kt < NKT; ++kt)
#pragma unroll
        for (int i = 0; i < 4; ++i) mx = fmaxf(mx, s[kt][i]);
    mx = fmaxf(mx, __shfl_xor(mx, 16)); mx = fmaxf(mx, __shfl_xor(mx, 32));
    const float mn = fmaxf(m, mx), alpha = ex2(m - mn); m = mn; float ps = 0.f;
#pragma unroll
    for (int kt = 0; kt < NKT; ++kt)
#pragma unroll
        for (int i = 0; i < 4; ++i) { const float p = s[kt][i] <= -1e29f ? 0.f : ex2(s[kt][i] - mn); s[kt][i] = p; ps += p; }
    l = l * alpha + ps;
#pragma unroll
    for (int c = 0; c < 16; ++c) o[c] = o[c] * alpha;
#pragma unroll
    for (int k2 = 0; k2 < NKT / 2; ++k2) { v4u pw; pw.x = pk2(s[2 * k2][0], s[2 * k2][1]); pw.y = pk2(s[2 * k2][2], s[2 * k2][3]); pw.z = pk2(s[2 * k2 + 1][0], s[2 * k2 + 1][1]); pw.w = pk2(s[2 * k2 + 1][2], s[2 * k2 + 1][3]);
        const bf16x8 pf = __builtin_bit_cast(bf16x8, pw);
        const LAS unsigned char* vb = imgw + (32 * k2 + 4 * fq + (fr >> 2)) * KSTR + 8 * (fr & 3);
#pragma unroll
        for (int c4 = 0; c4 < 16; c4 += 4) { v4i16 lo[4], hi[4];
#pragma unroll
            for (int c = 0; c < 4; ++c) { lo[c] = lds_tr(vb + (c4 + c) * 32); hi[c] = lds_tr(vb + 16 * KSTR + (c4 + c) * 32); }
#pragma unroll
            for (int c = 0; c < 4; ++c) o[c4 + c] = mfma16((bf16x8){lo[c][0], lo[c][1], lo[c][2], lo[c][3], hi[c][0], hi[c][1], hi[c][2], hi[c][3]}, pf, o[c4 + c]);
            __builtin_amdgcn_sched_barrier(0); } }
}
__device__ __forceinline__ void load_qfrags(bf16x8 (&qf)[10], const bf16* qrow, int head, int fq, const f32x2* ropetab, int posidx) {
#pragma unroll
    for (int ks = 0; ks < 8; ++ks) qf[ks] = *(const bf16x8*)(qrow + head * 256 + 32 * ks + 8 * fq);
    const v4u a = *(const v4u*)(qrow + 2048 + head * 64 + 8 * fq), b = *(const v4u*)(qrow + 2048 + head * 64 + 32 + 8 * fq);
    const f32x2* tb = ropetab + (size_t)posidx * 32 + 8 * fq;
    const unsigned aw[4] = {a.x, a.y, a.z, a.w}, bw[4] = {b.x, b.y, b.z, b.w}; unsigned o1[4], o2[4];
#pragma unroll
    for (int e = 0; e < 4; ++e) { const f32x2 c0 = tb[2 * e], c1 = tb[2 * e + 1]; const float x1l = bflo(aw[e]), x1h = bfhi(aw[e]), x2l = bflo(bw[e]), x2h = bfhi(bw[e]);
        o1[e] = pk2(x1l * c0.x - x2l * c0.y, x1h * c1.x - x2h * c1.y); o2[e] = pk2(x2l * c0.x + x1l * c0.y, x2h * c1.x + x1h * c1.y); }
    qf[8] = __builtin_bit_cast(bf16x8, (v4u){o1[0], o1[1], o1[2], o1[3]}); qf[9] = __builtin_bit_cast(bf16x8, (v4u){o2[0], o2[1], o2[2], o2[3]});
}
__device__ __forceinline__ void attn_prompt_unit(Frame& F, int b, int qb) {
    const int fr = F.lane & 15, fq = F.lane >> 4, q0 = 16 * qb, NT = (q0 + 16 + 63) >> 6; const size_t rowbase = (size_t)b * 4096;
    const bf16* Q = WSP(const bf16, WS_Q); const bf16* KC = WSP(const bf16, WS_KC); bf16* CTX = WSP(bf16, WS_CTX);
    bf16x8 qf[10]; load_qfrags(qf, Q + (rowbase + q0 + fr) * 2560, F.wave, fq, WSP(const f32x2, WS_ROPE), q0 + fr);
    f32x4 o[16];
#pragma unroll
    for (int c = 0; c < 16; ++c) o[c] = (f32x4){0.f, 0.f, 0.f, 0.f};
    float m = -1e30f, l = 0.f;
    v4u st[5];
#define PLOAD(T) do { _Pragma("unroll") for (int i = 0; i < 5; ++i) { const int cid = F.tid + 512 * i, r = cid / 40, ch = cid % 40; st[i] = *(const v4u*)(KC + (rowbase + 64 * (T) + r) * 320 + ch * 8); } } while (0)
#define PSTORE(buf) do { _Pragma("unroll") for (int i = 0; i < 5; ++i) { const int cid = F.tid + 512 * i, r = cid / 40, ch = cid % 40; *(LAS v4u*)(F.lds + (buf) * KIMG + r * KSTR + ch * 16) = st[i]; } } while (0)
    PLOAD(0); PSTORE(0); __syncthreads();
    for (int T = 0; T < NT; ++T) {
        if (T + 1 < NT) PLOAD(T + 1);
        attn_core<4>(F.lds + (T & 1) * KIMG, qf, o, m, l, fr, fq, T == NT - 1, 64 * T, q0 + fr);
        if (T + 1 < NT) PSTORE((T + 1) & 1);
        __syncthreads();
    }
#undef PLOAD
#undef PSTORE
    float lt = l + __shfl_xor(l, 16); lt += __shfl_xor(lt, 32); const float inv = 1.0f / lt;
    bf16* op = CTX + (rowbase + q0 + fr) * 2048 + F.wave * 256 + 4 * fq;
#pragma unroll
    for (int c = 0; c < 16; ++c) *(v2u*)(op + 16 * c) = (v2u){pk2(o[c][0] * inv, o[c][1] * inv), pk2(o[c][2] * inv, o[c][3] * inv)};
}
__device__ __forceinline__ void attn_sample_unit(Frame& F, const Args& A, int b, int sp) {
    const int fr = F.lane & 15, fq = F.lane >> 4, j = F.wave & 3, kh = F.wave >> 2, head = 2 * j + (fr >> 3), tok = fr & 7;
    const bf16* Q = WSP(const bf16, WS_Q); const bf16* KC = WSP(const bf16, WS_KC);
    const float* cckv = A.in[2]; const float* ckr = A.in[3]; const int* ptab = (const int*)A.in[5] + b * 64 + 32 * sp;
    bf16x8 qf[10]; load_qfrags(qf, Q + ((size_t)NP_ROWS + b * 8 + tok) * 2560, head, fq, WSP(const f32x2, WS_ROPE), 4096 + tok);
    f32x4 o[16];
#pragma unroll
    for (int c = 0; c < 16; ++c) o[c] = (f32x4){0.f, 0.f, 0.f, 0.f};
    float m = -1e30f, l = 0.f;
    f32x4 sc[8], sk[2];
#define SLOAD(T) do { const size_t kr0 = (size_t)ptab[(T) >> 1] * 128 + ((T) & 1) * 64; \
        _Pragma("unroll") for (int i = 0; i < 8; ++i) { const int cid = F.tid + 512 * i; sc[i] = __builtin_nontemporal_load((const f32x4*)(cckv + (kr0 + (cid >> 6)) * 256 + (cid & 63) * 4)); } \
        _Pragma("unroll") for (int i = 0; i < 2; ++i) { const int cid = F.tid + 512 * i; sk[i] = __builtin_nontemporal_load((const f32x4*)(ckr + (kr0 + (cid >> 4)) * 64 + (cid & 15) * 4)); } } while (0)
#define SSTORE(buf) do { \
        _Pragma("unroll") for (int i = 0; i < 8; ++i) { const int cid = F.tid + 512 * i; *(LAS v2u*)(F.lds + (buf) * KIMG + (cid >> 6) * KSTR + (cid & 63) * 8) = (v2u){pk2(sc[i][0], sc[i][1]), pk2(sc[i][2], sc[i][3])}; } \
        _Pragma("unroll") for (int i = 0; i < 2; ++i) { const int cid = F.tid + 512 * i; *(LAS v2u*)(F.lds + (buf) * KIMG + (cid >> 4) * KSTR + 512 + (cid & 15) * 8) = (v2u){pk2(sk[i][0], sk[i][1]), pk2(sk[i][2], sk[i][3])}; } } while (0)
    SLOAD(0); SSTORE(0); __syncthreads();
    for (int T = 0; T < 64; ++T) {
        if (T + 1 < 64) SLOAD(T + 1);
        attn_core<2>(F.lds + (T & 1) * KIMG + 32 * kh * KSTR, qf, o, m, l, fr, fq, false, 0, 0);
        if (T + 1 < 64) SSTORE((T + 1) & 1);
        __syncthreads();
    }
#undef SLOAD
#undef SSTORE
    if (sp == 1) {
#pragma unroll
        for (int i = 0; i < 5; ++i) { const int cid = F.tid + 512 * i, r = cid / 40, ch = cid % 40; v4u v = (v4u){0u, 0u, 0u, 0u};
            if (r < 8) v = *(const v4u*)(KC + ((size_t)NP_ROWS + b * 8 + r) * 320 + ch * 8);
            *(LAS v4u*)(F.lds + r * KSTR + ch * 16) = v; }
        __syncthreads();
        attn_core<2>(F.lds + 32 * kh * KSTR, qf, o, m, l, fr, fq, true, 32 * kh, tok);
        __syncthreads();
    }
    LAS float* mg = (LAS float*)F.lds;
    if (kh == 1) {
#pragma unroll
        for (int c = 0; c < 16; ++c)
#pragma unroll
            for (int i = 0; i < 4; ++i) mg[(j * 66 + c * 4 + i) * 64 + F.lane] = o[c][i];
        mg[(j * 66 + 64) * 64 + F.lane] = m; mg[(j * 66 + 65) * 64 + F.lane] = l; }
    __syncthreads();
    if (kh == 0) { const float m2 = mg[(j * 66 + 64) * 64 + F.lane], l2 = mg[(j * 66 + 65) * 64 + F.lane]; const float mt = fmaxf(m, m2), a1 = ex2(m - mt), a2 = ex2(m2 - mt);
        float lt = l * a1 + l2 * a2; lt += __shfl_xor(lt, 16); lt += __shfl_xor(lt, 32);
        const size_t prow = ((size_t)b * 2 + sp) * 64 + 16 * j + fr; float* po = WSP(float, WS_PARTO) + prow * 256 + 4 * fq;
#pragma unroll
        for (int c = 0; c < 16; ++c) { f32x4 v;
#pragma unroll
            for (int i = 0; i < 4; ++i) v[i] = o[c][i] * a1 + mg[(j * 66 + c * 4 + i) * 64 + F.lane] * a2;
            *(f32x4*)(po + 16 * c) = v; }
        if (fq == 0) *(f32x2*)(WSP(float, WS_PARTML) + prow * 2) = (f32x2){mt, lt}; }
    __syncthreads();
}
__device__ __forceinline__ void attn_phase(Frame& F, const Args& A) {
    const int c = blockIdx.x;
    if (c & 1) for (int su = c; su < 256; su += F.G) attn_sample_unit(F, A, su >> 1, su & 1);
    for (int p = c; p < 512; p += F.G) { const int b = p >> 7, x = p & 127; attn_prompt_unit(F, b, x); attn_prompt_unit(F, b, 255 - x); }
    if (!(c & 1)) for (int su = c; su < 256; su += F.G) attn_sample_unit(F, A, su >> 1, su & 1);
}
__device__ __forceinline__ void attn_combine_phase(Frame& F) {
    const size_t gt = (size_t)blockIdx.x * NTHR + F.tid, NGT = (size_t)F.G * NTHR;
    const float* po = WSP(const float, WS_PARTO); const float* pml = WSP(const float, WS_PARTML); bf16* CTX = WSP(bf16, WS_CTX);
    for (size_t i = gt; i < (size_t)128 * 64 * 64; i += NGT) { const int b = (int)(i >> 12), r64 = (int)(i >> 6) & 63, d4 = (int)(i & 63) * 4;
        const size_t p0 = ((size_t)b * 2) * 64 + r64, p1 = p0 + 64; const f32x2 ml0 = *(const f32x2*)(pml + p0 * 2), ml1 = *(const f32x2*)(pml + p1 * 2);
        const float mt = fmaxf(ml0.x, ml1.x), a0 = ex2(ml0.x - mt), a1 = ex2(ml1.x - mt), inv = 1.0f / (ml0.y * a0 + ml1.y * a1);
        const f32x4 v = (*(const f32x4*)(po + p0 * 256 + d4) * a0 + *(const f32x4*)(po + p1 * 256 + d4) * a1) * inv;
        const int head = 2 * (r64 >> 4) + ((r64 & 15) >> 3), tok = r64 & 7;
        *(v2u*)(CTX + ((size_t)NP_ROWS + b * 8 + tok) * 2048 + head * 256 + d4) = (v2u){pk2(v[0], v[1]), pk2(v[2], v[3])}; }
}

__global__ void __launch_bounds__(NTHR, 2) mk_fwd(Args args) {
    extern __shared__ __attribute__((aligned(16))) unsigned char lds_raw[];
    Frame F;
    F.lds = (LAS unsigned char*)lds_raw;
    F.tid = threadIdx.x; F.lane = F.tid & 63; F.wave = __builtin_amdgcn_readfirstlane(F.tid >> 6); F.G = gridDim.x;
    const Args& A = args;
    F.out = args.out; F.ws = args.ws;
    volatile LAS unsigned* MISC = (volatile LAS unsigned*)(F.lds + MISC_OFF);
    for (int u = F.tid; u < (LDS_BYTES - RING_BYTES) / 4; u += NTHR) ((LAS unsigned*)(F.lds + RING_BYTES))[u] = 0u;
    __syncthreads();
    gu32* ctl = (gu32*)(F.ws + WS_CTL);
    XcdBarrier bar = xcd_barrier_post((unsigned*)(ctl + CW_BAR) + args.li * XCD_BAR_WORDS, MISC + 8);
    const int lo = args.ph_lo, hi = args.ph_hi;
#define IN(k) (lo <= (k) && (k) < hi)
#define SEAM(k) do { if (IN(k) && IN((k) + 1)) xcd_barrier(bar); } while (0)
    const float* MOD = WSP(const float, WS_MOD);
#define MODP(layer, chunk) (MOD + (size_t)(layer) * NCOND * 6144 + (chunk) * 1024)
#define GEMM(EpiT, E, Aptr, Bptr, Mv, Nv, Kv) do { pg8::Gemm g_{(const pg8::bf16_t*)(Aptr), (const pg8::bf16_t*)(Bptr), (Mv), (Nv), (Kv)}; pg8::StaticOrder S_; S_.init((Mv), (Nv), F.G, (int)blockIdx.x); \
        pg8::gemm_phase<EpiT, pg8::StaticOrder, true, true>(F.lds, g_, S_, E); } while (0)

    if (IN(0)) { p0_prologue(F, A); } SEAM(0);
    if (IN(1)) { pg8::EpiAda E{WSP(float, WS_MOD), A.in[9]}; GEMM(pg8::EpiAda, E, WSP(bf16, WS_AADA), WSP(bf16, WS_WADA), 256, 24576, 1024); } SEAM(1);
    if (IN(2)) { p2_first_h(F, A); } SEAM(2);

#define FFN_PHASES(L, B) \
    if (IN(B)) { pg8::EpiSwiglu E{WSP(pg8::bf16_t, WS_ACT)}; GEMM(pg8::EpiSwiglu, E, WSP(bf16, WS_HBUF), WSP(bf16, WS_WGU + (L) * SZ_WGU), M_ROWS, 2 * FF, 1024); } SEAM(B); \
    if (IN((B) + 1)) { pg8::EpiResid E{WSP(const float, WS_XRES), WSP(float, WS_PRE), MODP(L, 5), nullptr}; GEMM(pg8::EpiResid, E, WSP(bf16, WS_ACT), WSP(bf16, WS_WDN + (L) * SZ_WDN), M_ROWS, 1024, FF); } SEAM((B) + 1); \
    if (IN((B) + 2)) { ln_phase(F, A.in[12] + (L) * 1024, A.in[13] + (L) * 1024, (L) == 3 ? F.out + O_Y : WSP(float, WS_XRES), (L) == 3 ? nullptr : MODP((L) + 1, 0)); } SEAM((B) + 2);
#define MIXLN_PHASE(L, B) if (IN(B)) { ln_phase(F, A.in[10] + (L) * 1024, A.in[11] + (L) * 1024, WSP(float, WS_XRES), MODP(L, 3)); } SEAM(B);
#define GMLP_PHASES(L, J, B) \
    if (IN(B)) { pg8::EpiGmlpIn E{WSP(pg8::bf16_t, WS_U), WSP(pg8::bf16_t, WS_V), WSP(pg8::f32x2, WS_STATS)}; GEMM(pg8::EpiGmlpIn, E, WSP(bf16, WS_HBUF), WSP(bf16, WS_WIN + (J) * SZ_WIN), M_ROWS, 4096, 1024); } SEAM(B); \
    if (IN((B) + 1)) { spatial_phase(F, A, J); } SEAM((B) + 1); \
    if (IN((B) + 2)) { pg8::EpiResid E{WSP(const float, WS_XRES), WSP(float, WS_PRE), MODP(L, 2), nullptr}; GEMM(pg8::EpiResid, E, WSP(bf16, WS_U), WSP(bf16, WS_WOUT + (J) * SZ_WOUT), M_ROWS, 1024, 2048); } SEAM((B) + 2);

    GMLP_PHASES(0, 0, 3)
    MIXLN_PHASE(0, 6)
    FFN_PHASES(0, 7)
    if (IN(10)) { pg8::EpiGlu E{WSP(pg8::bf16_t, WS_GLU), A.in[24], F.out + O_CONV_P, F.out + O_CONV_S}; GEMM(pg8::EpiGlu, E, WSP(bf16, WS_HBUF), WSP(bf16, WS_WPW1), M_ROWS, 2048, 1024); } SEAM(10);
    if (IN(11)) { dwconv_phase(F, A); } SEAM(11);
    if (IN(12)) { pg8::EpiResid E{WSP(const float, WS_XRES), WSP(float, WS_PRE), MODP(1, 2), A.in[30]}; GEMM(pg8::EpiResid, E, WSP(bf16, WS_CONVO), WSP(bf16, WS_WPW2), M_ROWS, 1024, 1024); } SEAM(12);
    MIXLN_PHASE(1, 13)
    FFN_PHASES(1, 14)
    if (IN(17)) { pg8::EpiF32 E{WSP(float, WS_DPROJ), 768}; GEMM(pg8::EpiF32, E, WSP(bf16, WS_HBUF), WSP(bf16, WS_WDOWN), M_ROWS, 768, 1024); } SEAM(17);
    if (IN(18)) { mla_post_phase(F, A); } SEAM(18);
    if (IN(19)) { pg8::EpiQ E{WSP(pg8::bf16_t, WS_Q), QSCALE}; GEMM(pg8::EpiQ, E, WSP(bf16, WS_QLAT), WSP(bf16, WS_WQC), M_ROWS, 2560, 384); } SEAM(19);
    if (IN(20)) { attn_phase(F, A); } SEAM(20);
    if (IN(21)) { attn_combine_phase(F); } SEAM(21);
    if (IN(22)) { pg8::EpiResid E{WSP(const float, WS_XRES), WSP(float, WS_PRE), MODP(2, 2), nullptr}; GEMM(pg8::EpiResid, E, WSP(bf16, WS_CTX), WSP(bf16, WS_WVO), M_ROWS, 1024, 2048); } SEAM(22);
    MIXLN_PHASE(2, 23)
    FFN_PHASES(2, 24)
    GMLP_PHASES(3, 1, 27)
    MIXLN_PHASE(3, 30)
    FFN_PHASES(3, 31)
#undef IN
#undef SEAM
}

extern "C" void kernel_launch(void* const* d_in, const int* in_sizes, int n_in, void* d_out, int out_size, void* d_ws, size_t ws_size, hipStream_t stream) {
    static int grid = 0;
    if (grid == 0) {
        if (n_in != 38 || (size_t)out_size != O_END || ws_size < WS_END) { fprintf(stderr, "kernel_launch: unexpected shapes (n_in %d, out %d, ws %zu)\n", n_in, out_size, ws_size); grid = -1; return; }
        int dev = 0, cus = 0, per_cu = 0;
        if (hipGetDevice(&dev) != hipSuccess || hipDeviceGetAttribute(&cus, hipDeviceAttributeMultiprocessorCount, dev) != hipSuccess) { grid = -1; return; }
        if (hipFuncSetAttribute((const void*)mk_fwd, hipFuncAttributeMaxDynamicSharedMemorySize, LDS_BYTES) != hipSuccess) { fprintf(stderr, "kernel_launch: hipFuncSetAttribute failed\n"); grid = -1; return; }
        if (hipOccupancyMaxActiveBlocksPerMultiprocessor(&per_cu, (const void*)mk_fwd, NTHR, LDS_BYTES) != hipSuccess || per_cu < 1) fprintf(stderr, "kernel_launch: occupancy query reports %d\n", per_cu);
        (void)hipGetLastError();
        grid = cus;
    }
    if (grid < 0) return;
    if (hipMemsetAsync((char*)d_ws + WS_CTL, 0, CTL_ZERO_BYTES, stream) != hipSuccess) return;
    Args a{};
    for (int i = 0; i < 38; ++i) a.in[i] = (const float*)d_in[i];
    a.out = (float*)d_out; a.ws = (unsigned char*)d_ws;
    constexpr int NL = MK_N_LAUNCHES;
    for (int li = 0; li < NL; ++li) {
        a.ph_lo = (int)((long)NPH * li / NL); a.ph_hi = (int)((long)NPH * (li + 1) / NL); a.li = li; a.pad = 0;
        hipLaunchKernelGGL(mk_fwd, dim3(grid), dim3(NTHR), LDS_BYTES, stream, a);
    }
}
```

```cpp
#include <hip/hip_runtime.h>
#include <cstdio>
#include <cstdint>
#include <cmath>
#define PROBE_BUILD 0
#define PROBE_CLS -1
namespace pg8 {
#define PG8_LAS __attribute__((address_space(3)))
typedef unsigned short bf16_t;
typedef short bf16x8 __attribute__((ext_vector_type(8)));
typedef float f32x4 __attribute__((ext_vector_type(4)));
typedef unsigned u32x4 __attribute__((ext_vector_type(4)));
constexpr int BM = 256, BK = 64, HALF = 128, HTB = HALF * BK * 2  , STAGE_BYTES = 8 * HTB, NXCD = 8, WGM = 8;

__host__ __device__ __forceinline__ int lds_byte(int r, int c) { const int st = (r >> 4) * 2 + (c >> 5), rr = r & 15, cc = c & 31, ob = rr * 64 + cc * 2; return st * 1024 + (ob ^ (((ob >> 9) & 1) << 5)); }
__host__ __device__ __forceinline__ void stage_rc(int b, int& R, int& C) { const int st = b / 1024, sb = b % 1024, swz = sb ^ (((sb >> 9) & 1) << 5); R = (st >> 1) * 16 + swz / 64; C = (st & 1) * 32 + (swz % 64) / 2; }
__host__ __device__ __forceinline__ int perm32(int rho) { const int n = rho >> 4, i = rho & 15; return 8 * (i >> 2) + 4 * n + (i & 3); }

struct Unit { int pm, pn, kz; };
struct Gemm { const bf16_t* A; const bf16_t* Bt; int M, N, K, lda, ldb; };

struct StaticOrder {
    int nM, nN, nwg, G, c;
    __host__ __device__ void init(int M, int N, int G_, int c_) { nM = M / BM; nN = N / BM; nwg = nM * nN; G = G_; c = c_; }
    __host__ __device__ bool next(int i, Unit& u) const {
        const long L = (long)i * G + c; if (L >= nwg) return false;
        int wgid = (int)L; { const int q = nwg / NXCD, r = nwg % NXCD, xcd = wgid % NXCD, off = wgid / NXCD; wgid = (xcd < r ? xcd * (q + 1) : r * (q + 1) + (xcd - r) * q) + off; }
        const int nig = WGM * nN, gid = wgid / nig, fm = gid * WGM, gsz = (nM - fm) < WGM ? (nM - fm) : WGM;
        u.pm = fm + ((wgid % nig) % gsz); u.pn = (wgid % nig) / gsz; u.kz = 0; return true;
    }
    __device__ __forceinline__ void a_ready(const Unit&) const {}
    __device__ __forceinline__ void done(const Unit&) const {}
};

struct SplitOrder {
    int pm0, nks, G, c;
    __host__ __device__ bool next(int i, Unit& u) const { const int L = i * G + c; if (L >= 16 * nks) return false; u.kz = L >> 4; u.pm = pm0 + ((L & 15) >> 2); u.pn = L & 3; return true; }
    __device__ __forceinline__ void a_ready(const Unit&) const {}
    __device__ __forceinline__ void done(const Unit&) const {}
};

__device__ __forceinline__ unsigned cvt_pk_bf16(float lo, float hi) { unsigned r; asm volatile("v_cvt_pk_bf16_f32 %0, %1, %2" : "=v"(r) : "v"(lo), "v"(hi)); return r; }
typedef float f32x2 __attribute__((ext_vector_type(2)));
__device__ __forceinline__ f32x2 gelu_pk(f32x2 v) {
    const f32x2 av = __builtin_elementwise_abs(v), d = av * 0.2316418882f + 1.0f;
    f32x2 t; t.x = __builtin_amdgcn_rcpf(d.x); t.y = __builtin_amdgcn_rcpf(d.y);
    f32x2 q = t * 0.5307027145f + (-0.7265760135f); q = q * t + 0.7107068705f; q = q * t + (-0.142248368f); q = q * t + 0.127414796f; q = q * t;
    const f32x2 s = (v * v) * (-0.72134752044f);
    f32x2 e; e.x = __builtin_amdgcn_exp2f(s.x); e.y = __builtin_amdgcn_exp2f(s.y);
    const f32x2 m = v * (q * e), r = v - m;
    f32x2 o; o.x = v.x < 0.f ? m.x : r.x; o.y = v.y < 0.f ? m.y : r.y; return o;
}

constexpr int NP_ROWS = 16384, NS_ROWS = 1024, M_ROWS = NP_ROWS + NS_ROWS, NCOND = 132, DM = 1024;
constexpr float DN_ALPHA = 1.681792830507429f;
__device__ __forceinline__ int cond_of(int row) { return row < NP_ROWS ? (row >> 12) : 4 + ((row - NP_ROWS) >> 3); }
__device__ __forceinline__ int posidx_of(int row) { return row < NP_ROWS ? (row & 4095) : 4096 + ((row - NP_ROWS) & 7); }
__device__ __forceinline__ float silu_f(float g) { return g * __builtin_amdgcn_rcpf(1.0f + __builtin_amdgcn_exp2f(-1.4426950408889634f * g)); }
__device__ __forceinline__ float sigm_f(float g) { return __builtin_amdgcn_rcpf(1.0f + __builtin_amdgcn_exp2f(-1.4426950408889634f * g)); }


struct EpiGmlpIn {
    static constexpr bool PERM = true, AFTER_DRAIN = false;
    bf16_t* U; bf16_t* V; f32x2* stats;
    __device__ __forceinline__ void operator()(const f32x4 (&acc)[2][2][4][2], const Unit& u, int wr, int wc, int fr, int fq) const {
        const int row0 = u.pm * BM + wr * 64 + fr; const bool isv = u.pn >= 8;
        bf16_t* base = isv ? V : U; const int col0 = (isv ? (u.pn - 8) : u.pn) * BM + wc * 32 + 8 * fq;
#pragma unroll
        for (int ai = 0; ai < 2; ++ai)
#pragma unroll
            for (int m = 0; m < 4; ++m) { const int row = row0 + ai * HALF + m * 16; bf16_t* rowp = base + (size_t)row * 2048 + col0; float s = 0.f, ss = 0.f;
#pragma unroll
                for (int bj = 0; bj < 2; ++bj) { const f32x4 v0 = acc[ai][bj][m][0], v1 = acc[ai][bj][m][1];
                    const f32x2 a = gelu_pk((f32x2){v0[0], v0[1]}), b = gelu_pk((f32x2){v0[2], v0[3]}), c = gelu_pk((f32x2){v1[0], v1[1]}), d = gelu_pk((f32x2){v1[2], v1[3]});
                    s += ((a.x + a.y) + (b.x + b.y)) + ((c.x + c.y) + (d.x + d.y));
                    ss += ((a.x * a.x + a.y * a.y) + (b.x * b.x + b.y * b.y)) + ((c.x * c.x + c.y * c.y) + (d.x * d.x + d.y * d.y));
                    u32x4 w; w.x = cvt_pk_bf16(a.x, a.y); w.y = cvt_pk_bf16(b.x, b.y); w.z = cvt_pk_bf16(c.x, c.y); w.w = cvt_pk_bf16(d.x, d.y);
                    *(u32x4*)(rowp + bj * HALF) = w; }
                if (isv) { s += __shfl_xor(s, 16); s += __shfl_xor(s, 32); ss += __shfl_xor(ss, 16); ss += __shfl_xor(ss, 32);
                    if (fq == 0) stats[(size_t)row * 32 + (u.pn - 8) * 4 + wc] = (f32x2){s, ss}; } }
    }
};
struct EpiResid {
    static constexpr bool PERM = false, AFTER_DRAIN = false;
    const float* x; float* pre; const float* gate;
    const float* bias;
    __device__ __forceinline__ void operator()(const f32x4 (&acc)[2][2][4][2], const Unit& u, int wr, int wc, int fr, int fq) const {
        const int row0 = u.pm * BM + wr * 64 + fr, col0 = u.pn * BM + wc * 32 + 4 * fq;
        f32x4 bv[2][2];
#pragma unroll
        for (int bj = 0; bj < 2; ++bj)
#pragma unroll
            for (int n = 0; n < 2; ++n) bv[bj][n] = bias ? *(const f32x4*)(bias + col0 + bj * HALF + n * 16) : (f32x4){0.f, 0.f, 0.f, 0.f};
#pragma unroll
        for (int ai = 0; ai < 2; ++ai)
#pragma unroll
            for (int m = 0; m < 4; ++m) { const int row = row0 + ai * HALF + m * 16; const float* gp = gate + (size_t)cond_of(row) * 6144 + col0;
                const float* xp = x + (size_t)row * DM + col0; float* pp = pre + (size_t)row * DM + col0;
#pragma unroll
                for (int bj = 0; bj < 2; ++bj)
#pragma unroll
                    for (int n = 0; n < 2; ++n) { const int o = bj * HALF + n * 16; const f32x4 xv = *(const f32x4*)(xp + o), gv = *(const f32x4*)(gp + o);
                        *(f32x4*)(pp + o) = xv * DN_ALPHA + gv * (acc[ai][bj][m][n] + bv[bj][n]); }
                asm volatile("" ::: "memory"); }
    }
};
struct EpiSwiglu {
    static constexpr bool PERM = true, AFTER_DRAIN = false;
    bf16_t* act;
    __device__ __forceinline__ void operator()(const f32x4 (&acc)[2][2][4][2], const Unit& u, int wr, int wc, int fr, int fq) const {
        const int row0 = u.pm * BM + wr * 64 + fr, col0 = u.pn * HALF + wc * 32 + 8 * fq;
#pragma unroll
        for (int ai = 0; ai < 2; ++ai)
#pragma unroll
            for (int m = 0; m < 4; ++m) { const int row = row0 + ai * HALF + m * 16; float o[8];
#pragma unroll
                for (int n = 0; n < 2; ++n)
#pragma unroll
                    for (int e = 0; e < 4; ++e) o[n * 4 + e] = silu_f(acc[ai][0][m][n][e]) * acc[ai][1][m][n][e];
                u32x4 w; w.x = cvt_pk_bf16(o[0], o[1]); w.y = cvt_pk_bf16(o[2], o[3]); w.z = cvt_pk_bf16(o[4], o[5]); w.w = cvt_pk_bf16(o[6], o[7]);
                *(u32x4*)(act + (size_t)row * 2816 + col0) = w; }
    }
};
struct EpiGlu {
    static constexpr bool PERM = true, AFTER_DRAIN = false;
    bf16_t* glu; const float* bias; float* st_p; float* st_s;
    __device__ __forceinline__ void operator()(const f32x4 (&acc)[2][2][4][2], const Unit& u, int wr, int wc, int fr, int fq) const {
        const int row0 = u.pm * BM + wr * 64 + fr, col0 = u.pn * HALF + wc * 32 + 8 * fq;
        f32x4 b0[2], b1[2];
#pragma unroll
        for (int n = 0; n < 2; ++n) { b0[n] = *(const f32x4*)(bias + col0 + 4 * n); b1[n] = *(const f32x4*)(bias + 1024 + col0 + 4 * n); }
#pragma unroll
        for (int ai = 0; ai < 2; ++ai)
#pragma unroll
            for (int m = 0; m < 4; ++m) { const int row = row0 + ai * HALF + m * 16; float o[8];
#pragma unroll
                for (int n = 0; n < 2; ++n)
#pragma unroll
                    for (int e = 0; e < 4; ++e) o[n * 4 + e] = (acc[ai][0][m][n][e] + b0[n][e]) * sigm_f(acc[ai][1][m][n][e] + b1[n][e]);
                u32x4 w; w.x = cvt_pk_bf16(o[0], o[1]); w.y = cvt_pk_bf16(o[2], o[3]); w.z = cvt_pk_bf16(o[4], o[5]); w.w = cvt_pk_bf16(o[6], o[7]);
                *(u32x4*)(glu + (size_t)row * DM + col0) = w;
                float* sp = nullptr;
                if (row < NP_ROWS) { const int t = row & 4095; if (t >= 4066) sp = st_p + ((size_t)(row >> 12) * 30 + (t - 4066)) * DM + col0; }
                else { const int s = row - NP_ROWS; sp = st_s + ((size_t)(s >> 3) * 30 + 22 + (s & 7)) * DM + col0; }
                if (sp) { *(f32x4*)sp = (f32x4){o[0], o[1], o[2], o[3]}; *(f32x4*)(sp + 4) = (f32x4){o[4], o[5], o[6], o[7]}; } }
    }
};
struct EpiF32 {
    static constexpr bool PERM = false, AFTER_DRAIN = false;
    float* C; int ldc;
    __device__ __forceinline__ void operator()(const f32x4 (&acc)[2][2][4][2], const Unit& u, int wr, int wc, int fr, int fq) const {
        const int row0 = u.pm * BM + wr * 64 + fr, col0 = u.pn * BM + wc * 32 + 4 * fq;
#pragma unroll
        for (int ai = 0; ai < 2; ++ai)
#pragma unroll
            for (int m = 0; m < 4; ++m) { float* rowp = C + (size_t)(row0 + ai * HALF + m * 16) * ldc + col0;
#pragma unroll
                for (int bj = 0; bj < 2; ++bj)
#pragma unroll
                    for (int n = 0; n < 2; ++n) *(f32x4*)(rowp + bj * HALF + n * 16) = acc[ai][bj][m][n]; }
    }
};
struct EpiQ {
    static constexpr bool PERM = true, AFTER_DRAIN = false;
    bf16_t* q; float qscale;
    __device__ __forceinline__ void operator()(const f32x4 (&acc)[2][2][4][2], const Unit& u, int wr, int wc, int fr, int fq) const {
        const int row0 = u.pm * BM + wr * 64 + fr, col0 = u.pn * BM + wc * 32 + 8 * fq;
#pragma unroll
        for (int ai = 0; ai < 2; ++ai)
#pragma unroll
            for (int m = 0; m < 4; ++m) { bf16_t* rowp = q + (size_t)(row0 + ai * HALF + m * 16) * 2560 + col0;
#pragma unroll
                for (int bj = 0; bj < 2; ++bj) { const f32x4 v0 = acc[ai][bj][m][0] * qscale, v1 = acc[ai][bj][m][1] * qscale;
                    u32x4 w; w.x = cvt_pk_bf16(v0[0], v0[1]); w.y = cvt_pk_bf16(v0[2], v0[3]); w.z = cvt_pk_bf16(v1[0], v1[1]); w.w = cvt_pk_bf16(v1[2], v1[3]);
                    *(u32x4*)(rowp + bj * HALF) = w; } }
    }
};
struct EpiAda {
    static constexpr bool PERM = false, AFTER_DRAIN = false;
    float* mod; const float* bias;
    __device__ __forceinline__ void operator()(const f32x4 (&acc)[2][2][4][2], const Unit& u, int wr, int wc, int fr, int fq) const {
        const int row0 = u.pm * BM + wr * 64 + fr, col0 = u.pn * BM + wc * 32 + 4 * fq;
#pragma unroll
        for (int ai = 0; ai < 2; ++ai)
#pragma unroll
            for (int m = 0; m < 4; ++m) { const int row = row0 + ai * HALF + m * 16; if (row < NCOND) {
#pragma unroll
                for (int bj = 0; bj < 2; ++bj)
#pragma unroll
                    for (int n = 0; n < 2; ++n) { const int col = col0 + bj * HALF + n * 16, l = col / 6144, c = col - l * 6144;
                        *(f32x4*)(mod + ((size_t)l * NCOND + row) * 6144 + c) = acc[ai][bj][m][n] + *(const f32x4*)(bias + col); } } }
    }
};
struct EpiSlab {
    static constexpr bool PERM = false, AFTER_DRAIN = false;
    float* slab;
    __device__ __forceinline__ void operator()(const f32x4 (&acc)[2][2][4][2], const Unit& u, int wr, int wc, int fr, int fq) const {
        const int row0 = u.pm * BM + wr * 64 + fr - NP_ROWS, col0 = u.pn * BM + wc * 32 + 4 * fq; float* base = slab + (size_t)u.kz * NS_ROWS * DM;
#pragma unroll
        for (int ai = 0; ai < 2; ++ai)
#pragma unroll
            for (int m = 0; m < 4; ++m) { float* rowp = base + (size_t)(row0 + ai * HALF + m * 16) * DM + col0;
#pragma unroll
                for (int bj = 0; bj < 2; ++bj)
#pragma unroll
                    for (int n = 0; n < 2; ++n) *(f32x4*)(rowp + bj * HALF + n * 16) = acc[ai][bj][m][n]; }
    }
};
template <class Epi, class Sched, bool ALIGN_EPI = false, bool SP2 = false>
__device__ __forceinline__ void gemm_phase(PG8_LAS unsigned char* lds, const Gemm g, const Sched& S, const Epi& E) {
    const int tid = threadIdx.x, wid = __builtin_amdgcn_readfirstlane(tid >> 6), lane = tid & 63, wr = wid >> 2, wc = wid & 3, fr = lane & 15, fq = lane >> 4;
    const int K = g.K, nt = K / BK;
    unsigned voffA[2], voffB[2];
#pragma unroll
    for (int i = 0; i < 2; ++i) { int R, C; stage_rc(tid * 16 + i * 8192, R, C); const int Rb = Epi::PERM ? ((R & ~31) + perm32(R & 31)) : R;
        voffA[i] = (unsigned)(R * g.lda + C) * 2u; voffB[i] = (unsigned)(Rb * g.ldb + C) * 2u; }
    const size_t kstep = (size_t)(BK * 2);
    const size_t hstepA = (size_t)HALF * g.lda * 2, hstepB = (size_t)HALF * g.ldb * 2;
    const size_t tstepA = 2 * hstepA, tstepB = 2 * hstepB, zstep = (size_t)K * 2;
    const unsigned ldsw = (unsigned)wid * 1024u;
    const int aoff = lds_byte(wr * 64 + fr, fq * 8), boff = lds_byte(wc * 32 + fr, fq * 8);
#define PG8_SA(b, h) (((b) * 2 + (h)) * HTB)
#define PG8_SB(b, h) ((4 + (b) * 2 + (h)) * HTB)
#define PG8_STAGE(bufoff, gbase, voff) do { _Pragma("unroll") for (int _i = 0; _i < 2; ++_i) \
        __builtin_amdgcn_global_load_lds((const unsigned*)((const char*)(gbase) + (voff)[_i]), (PG8_LAS unsigned*)(lds + (bufoff) + ldsw + _i * 8192), 16, 0, 0); } while (0)
#define PG8_LDA(dst, b, h) do { _Pragma("unroll") for (int m = 0; m < 4; ++m) _Pragma("unroll") for (int k = 0; k < 2; ++k) dst[m][k] = *(const PG8_LAS bf16x8*)(lds + PG8_SA(b, h) + aoff + m * 2048 + k * 1024); } while (0)
#define PG8_LDB(dst, b, h) do { _Pragma("unroll") for (int n = 0; n < 2; ++n) _Pragma("unroll") for (int k = 0; k < 2; ++k) dst[n][k] = *(const PG8_LAS bf16x8*)(lds + PG8_SB(b, h) + boff + n * 2048 + k * 1024); } while (0)
#define PG8_MMA(ai, bj, At, Bt) do { __builtin_amdgcn_s_setprio(1); _Pragma("unroll") for (int m = 0; m < 4; ++m) _Pragma("unroll") for (int n = 0; n < 2; ++n) _Pragma("unroll") for (int k = 0; k < 2; ++k) \
        acc[ai][bj][m][n] = __builtin_amdgcn_mfma_f32_16x16x32_bf16(Bt[n][k], At[m][k], acc[ai][bj][m][n], 0, 0, 0); __builtin_amdgcn_s_setprio(0); } while (0)
#define PG8_WAIT_V(n) asm volatile("s_waitcnt vmcnt(" #n ")" ::: "memory")
#define PG8_WAIT_L(n) asm volatile("s_waitcnt lgkmcnt(" #n ")" ::: "memory")
#define PG8_BAR __builtin_amdgcn_s_barrier()
#define PG8_SCHED __builtin_amdgcn_sched_barrier(0)
    Unit cur, nxt; int ui = 0;
    if (!S.next(0, cur)) return;
    f32x4 acc[2][2][4][2];
#pragma unroll
    for (int a = 0; a < 2; ++a)
#pragma unroll
        for (int b = 0; b < 2; ++b)
#pragma unroll
            for (int m = 0; m < 4; ++m)
#pragma unroll
                for (int n = 0; n < 2; ++n) acc[a][b][m][n] = (f32x4){0.f, 0.f, 0.f, 0.f};
    bf16x8 At[4][2], B0[2][2], B1[2][2];
    const char* cA = (const char*)g.A + (size_t)cur.pm * tstepA + (size_t)cur.kz * zstep; const char* cB = (const char*)g.Bt + (size_t)cur.pn * tstepB + (size_t)cur.kz * zstep;
    S.a_ready(cur);
    if constexpr (SP2) {
        PG8_STAGE(PG8_SB(0, 0), cB, voffB); PG8_STAGE(PG8_SB(0, 1), cB + hstepB, voffB); PG8_STAGE(PG8_SA(0, 0), cA, voffA); PG8_STAGE(PG8_SA(0, 1), cA + hstepA, voffA);
        if (wr == 1) PG8_BAR;
        PG8_WAIT_V(2); PG8_BAR;
        PG8_STAGE(PG8_SB(1, 0), cB + kstep, voffB); PG8_STAGE(PG8_SA(1, 0), cA + kstep, voffA); PG8_STAGE(PG8_SB(1, 1), cB + hstepB + kstep, voffB);
        PG8_WAIT_V(6); PG8_BAR;
    } else {
        PG8_STAGE(PG8_SB(0, 0), cB, voffB); PG8_STAGE(PG8_SA(0, 0), cA, voffA); PG8_STAGE(PG8_SB(0, 1), cB + hstepB, voffB); PG8_STAGE(PG8_SA(0, 1), cA + hstepA, voffA);
        if (wr == 1) PG8_BAR;
        PG8_WAIT_V(4); PG8_BAR;
        PG8_STAGE(PG8_SB(1, 0), cB + kstep, voffB); PG8_STAGE(PG8_SA(1, 0), cA + kstep, voffA); PG8_STAGE(PG8_SB(1, 1), cB + hstepB + kstep, voffB);
        PG8_WAIT_V(6); PG8_BAR;
    }
    for (;;) {
        const bool has_next = S.next(ui + 1, nxt);
        const char* nA = has_next ? (const char*)g.A + (size_t)nxt.pm * tstepA + (size_t)nxt.kz * zstep : cA; const char* nB = has_next ? (const char*)g.Bt + (size_t)nxt.pn * tstepB + (size_t)nxt.kz * zstep : cB;
#pragma unroll 1
        for (int t = 0; t < nt; t += 2) {
            const bool last = (t == nt - 2);
            const char* a1 = cA + (size_t)(t + 1) * kstep;
            const char* a2 = last ? nA : cA + (size_t)(t + 2) * kstep; const char* b2 = last ? nB : cB + (size_t)(t + 2) * kstep;
            const char* a3 = a2 + kstep; const char* b3 = b2 + kstep;
            if (last && has_next) S.a_ready(nxt);
            if constexpr (SP2) {
            PG8_LDB(B0, 0, 0); PG8_LDB(B1, 0, 1); PG8_SCHED; PG8_LDA(At, 0, 0); PG8_STAGE(PG8_SA(1, 1), a1 + hstepA, voffA);
            PG8_WAIT_V(8); PG8_WAIT_L(0); PG8_BAR; PG8_MMA(0, 0, At, B0); PG8_MMA(0, 1, At, B1); PG8_BAR; PG8_SCHED;
            PG8_LDA(At, 0, 1); PG8_STAGE(PG8_SB(0, 0), b2, voffB); PG8_STAGE(PG8_SB(0, 1), b2 + hstepB, voffB); PG8_STAGE(PG8_SA(0, 0), a2, voffA);
            PG8_WAIT_V(8); PG8_WAIT_L(0); PG8_BAR; PG8_MMA(1, 0, At, B0); PG8_MMA(1, 1, At, B1); PG8_BAR; PG8_SCHED;
            PG8_LDB(B0, 1, 0); PG8_LDB(B1, 1, 1); PG8_SCHED; PG8_LDA(At, 1, 0); PG8_STAGE(PG8_SA(0, 1), a2 + hstepA, voffA);
            PG8_WAIT_V(8); PG8_WAIT_L(0); PG8_BAR; PG8_MMA(0, 0, At, B0); PG8_MMA(0, 1, At, B1); PG8_BAR; PG8_SCHED;
            PG8_LDA(At, 1, 1); PG8_STAGE(PG8_SB(1, 0), b3, voffB); PG8_STAGE(PG8_SB(1, 1), b3 + hstepB, voffB); PG8_STAGE(PG8_SA(1, 0), a3, voffA);
            PG8_WAIT_V(8); PG8_WAIT_L(0); PG8_BAR; PG8_MMA(1, 0, At, B0); PG8_MMA(1, 1, At, B1); PG8_BAR; PG8_SCHED;
            } else {
            PG8_LDB(B0, 0, 0); PG8_SCHED; PG8_LDA(At, 0, 0); PG8_STAGE(PG8_SA(1, 1), a1 + hstepA, voffA);
            PG8_WAIT_L(8); PG8_BAR; PG8_WAIT_L(0); PG8_MMA(0, 0, At, B0); PG8_BAR; PG8_SCHED;
            PG8_LDB(B1, 0, 1); PG8_STAGE(PG8_SB(0, 0), b2, voffB);
            PG8_BAR; PG8_WAIT_L(0); PG8_MMA(0, 1, At, B1); PG8_BAR;
            PG8_LDA(At, 0, 1); PG8_STAGE(PG8_SA(0, 0), a2, voffA);
            PG8_BAR; PG8_WAIT_L(0); PG8_MMA(1, 0, At, B0); PG8_BAR; PG8_SCHED;
            PG8_STAGE(PG8_SB(0, 1), b2 + hstepB, voffB);
            PG8_WAIT_V(6); PG8_BAR; PG8_MMA(1, 1, At, B1); PG8_BAR;
            PG8_LDB(B0, 1, 0); PG8_SCHED; PG8_LDA(At, 1, 0); PG8_STAGE(PG8_SA(0, 1), a2 + hstepA, voffA);
            PG8_WAIT_L(8); PG8_BAR; PG8_WAIT_L(0); PG8_MMA(0, 0, At, B0); PG8_BAR; PG8_SCHED;
            PG8_LDB(B1, 1, 1); PG8_STAGE(PG8_SB(1, 0), b3, voffB);
            PG8_BAR; PG8_WAIT_L(0); PG8_MMA(0, 1, At, B1); PG8_BAR;
            PG8_LDA(At, 1, 1); PG8_STAGE(PG8_SA(1, 0), a3, voffA);
            PG8_BAR; PG8_WAIT_L(0); PG8_MMA(1, 0, At, B0); PG8_BAR; PG8_SCHED;
            PG8_STAGE(PG8_SB(1, 1), b3 + hstepB, voffB);
            PG8_WAIT_V(6); PG8_BAR; PG8_MMA(1, 1, At, B1); PG8_BAR;
            }
        }
        if constexpr (ALIGN_EPI) { if (wr == 0) PG8_BAR; }
        if constexpr (!Epi::AFTER_DRAIN) { E(acc, cur, wr, wc, fr, fq); S.done(cur); }
        if (!has_next) break;
#pragma unroll
        for (int a = 0; a < 2; ++a)
#pragma unroll
            for (int b = 0; b < 2; ++b)
#pragma unroll
                for (int m = 0; m < 4; ++m)
#pragma unroll
                    for (int n = 0; n < 2; ++n) acc[a][b][m][n] = (f32x4){0.f, 0.f, 0.f, 0.f};
        cur = nxt; cA = nA; cB = nB; ++ui;
        if constexpr (ALIGN_EPI) { if (wr == 1) PG8_BAR; }
    }
    PG8_WAIT_V(0);
    if constexpr (!ALIGN_EPI) { if (wr == 0) PG8_BAR; }
    PG8_BAR;
    if constexpr (Epi::AFTER_DRAIN) { E.fused(acc, cur, wr, wc, fr, fq, lds, wid, lane); S.done(cur); }
#undef PG8_SA
#undef PG8_SB
#undef PG8_STAGE
#undef PG8_LDA
#undef PG8_LDB
#undef PG8_MMA
#undef PG8_WAIT_V
#undef PG8_WAIT_L
#undef PG8_BAR
#undef PG8_SCHED
}
}

using pg8::NP_ROWS; using pg8::NS_ROWS; using pg8::M_ROWS; using pg8::NCOND; using pg8::DM;
constexpr int NWAVES = 8, NTHR = 512;
constexpr int FF = 2816, GD = 2048, NLAYER = 4;
constexpr int NPH = 34;
#ifndef PROBE_BUILD
#define PROBE_BUILD 0
#endif
#ifndef PROBE_CLS
#define PROBE_CLS -1
#endif
#ifndef MK_N_LAUNCHES
#define MK_N_LAUNCHES 1
#endif
constexpr float LN_EPS = 1e-5f, RMS_EPS = 1e-6f;
constexpr float QSCALE = 0.07216878364870323f * 1.4426950408889634f;

constexpr size_t al256(size_t x) { return (x + 255) & ~(size_t)255; }
constexpr size_t WS_CTL = 0, CTL_ZERO_BYTES = 1u << 20;
constexpr size_t WS_WADA  = CTL_ZERO_BYTES;
constexpr size_t WS_WGU   = WS_WADA  + al256((size_t)24576 * 1024 * 2);
constexpr size_t SZ_WGU   = (size_t)5632 * 1024 * 2;
constexpr size_t WS_WDN   = WS_WGU   + 4 * SZ_WGU;
constexpr size_t SZ_WDN   = (size_t)1024 * 2816 * 2;
constexpr size_t WS_WIN   = WS_WDN   + 4 * SZ_WDN;
constexpr size_t SZ_WIN   = (size_t)4096 * 1024 * 2;
constexpr size_t WS_WOUT  = WS_WIN   + 2 * SZ_WIN;
constexpr size_t SZ_WOUT  = (size_t)1024 * 2048 * 2;
constexpr size_t WS_WPW1  = WS_WOUT  + 2 * SZ_WOUT;
constexpr size_t WS_WPW2  = WS_WPW1  + (size_t)2048 * 1024 * 2;
constexpr size_t WS_WDOWN = WS_WPW2  + (size_t)1024 * 1024 * 2;
constexpr size_t WS_WQC   = WS_WDOWN + (size_t)768 * 1024 * 2;
constexpr size_t WS_WVO   = WS_WQC   + (size_t)2560 * 384 * 2;
constexpr size_t WS_AADA  = WS_WVO   + (size_t)1024 * 2048 * 2;
constexpr size_t WS_MOD   = WS_AADA  + (size_t)256 * 1024 * 2;
constexpr size_t WS_ROPE  = WS_MOD   + al256((size_t)4 * 132 * 6144 * 4);
constexpr size_t WS_XRES  = WS_ROPE  + al256((size_t)4104 * 32 * 8);
constexpr size_t WS_PRE   = WS_XRES  + (size_t)M_ROWS * 1024 * 4;
constexpr size_t WS_HBUF  = WS_PRE   + (size_t)M_ROWS * 1024 * 4;
constexpr size_t WS_U     = WS_HBUF  + (size_t)M_ROWS * 1024 * 2;
constexpr size_t WS_V     = WS_U     + (size_t)M_ROWS * 2048 * 2;
constexpr size_t WS_STATS = WS_V     + (size_t)M_ROWS * 2048 * 2;
constexpr size_t WS_ACT   = WS_STATS + (size_t)M_ROWS * 32 * 8;
constexpr size_t WS_GLU   = WS_ACT   + (size_t)M_ROWS * 2816 * 2;
constexpr size_t WS_CONVO = WS_GLU   + (size_t)M_ROWS * 1024 * 2;
constexpr size_t WS_DPROJ = WS_CONVO + (size_t)M_ROWS * 1024 * 2;
constexpr size_t WS_QLAT  = WS_DPROJ + (size_t)M_ROWS * 768 * 4;
constexpr size_t WS_Q     = WS_QLAT  + (size_t)M_ROWS * 384 * 2;
constexpr size_t WS_KC    = WS_Q     + (size_t)M_ROWS * 2560 * 2;
constexpr size_t WS_CTX   = WS_KC    + (size_t)M_ROWS * 320 * 2;
constexpr size_t WS_PARTO = WS_CTX   + (size_t)M_ROWS * 2048 * 2;
constexpr size_t WS_PARTML= WS_PARTO + (size_t)128 * 2 * 64 * 256 * 4;
constexpr size_t WS_SLAB  = WS_PARTML + (size_t)128 * 2 * 64 * 2 * 4;
constexpr size_t WS_UM    = WS_SLAB + (size_t)11 * 1024 * 1024 * 4;
constexpr size_t WS_DUMX  = WS_UM + (size_t)M_ROWS * 2048 * 2;
constexpr size_t WS_DUMH  = WS_DUMX + (size_t)M_ROWS * 1024 * 4;
constexpr size_t WS_END   = WS_DUMH + (size_t)M_ROWS * 1024 * 2;
constexpr int CW_TMO = 0, CW_BAR = 4096;

constexpr size_t O_Y = 0, O_CKV_P = (size_t)M_ROWS * 1024, O_KR_P = O_CKV_P + (size_t)NP_ROWS * 256, O_CKV_S = O_KR_P + (size_t)NP_ROWS * 64, O_KR_S = O_CKV_S + (size_t)NS_ROWS * 256,
                 O_CONV_P = O_KR_S + (size_t)NS_ROWS * 64, O_CONV_S = O_CONV_P + (size_t)4 * 30 * 1024, O_GV = O_CONV_S + (size_t)128 * 30 * 1024, O_END = O_GV + (size_t)2 * 128 * 8 * 2048;

constexpr int RING_BYTES = 131072, MISC_OFF = RING_BYTES + 320, LDS_BYTES = 147456;

#define GAS __attribute__((address_space(1)))
#define LAS __attribute__((address_space(3)))
typedef unsigned short bf16;
typedef unsigned v4u __attribute__((ext_vector_type(4)));
typedef unsigned v2u __attribute__((ext_vector_type(2)));
typedef float f32x4 __attribute__((ext_vector_type(4)));
typedef float f32x2 __attribute__((ext_vector_type(2)));
typedef short bf16x8 __attribute__((ext_vector_type(8)));
typedef short v4i16 __attribute__((ext_vector_type(4)));
typedef GAS unsigned gu32;
#define RLX_AGENT __ATOMIC_RELAXED, __HIP_MEMORY_SCOPE_AGENT
__device__ __forceinline__ unsigned pk2(float lo, float hi) { return pg8::cvt_pk_bf16(lo, hi); }
__device__ __forceinline__ float bflo(unsigned w) { return __uint_as_float(w << 16); }
__device__ __forceinline__ float bfhi(unsigned w) { return __uint_as_float(w & 0xffff0000u); }
__device__ __forceinline__ float ex2(float x) { return __builtin_amdgcn_exp2f(x); }
__device__ __forceinline__ f32x4 mfma16(bf16x8 a, bf16x8 b, f32x4 c) { return __builtin_amdgcn_mfma_f32_16x16x32_bf16(a, b, c, 0, 0, 0); }
__device__ __forceinline__ v4i16 lds_tr(const LAS unsigned char* p) { return __builtin_amdgcn_ds_read_tr16_b64_v4i16((LAS v4i16*)p); }
__device__ __forceinline__ float wave_sum(float v) {
#pragma unroll
    for (int o = 1; o < 64; o <<= 1) v += __shfl_xor(v, o);
    return v;
}

#define XB_TMO      128
#define XB_XCNT(j)  (256  + 64 * (j))
#define XB_XSUB(j)  (1280 + 64 * (j))
#define XB_XGEN(j)  (2304 + 64 * (j))
#define XB_TOP      3328
#define XB_TOPGEN   3392
#define XCD_BAR_WORDS 3456
#define XB_SPIN_CAP (1u << 18)

__device__ __forceinline__ unsigned xb_ld(unsigned* p)              { return __hip_atomic_load(p, __ATOMIC_RELAXED, __HIP_MEMORY_SCOPE_AGENT); }
__device__ __forceinline__ unsigned xb_add(unsigned* p, unsigned v) { return __hip_atomic_fetch_add(p, v, __ATOMIC_RELAXED, __HIP_MEMORY_SCOPE_AGENT); }
__device__ __forceinline__ unsigned xb_xcc_id() { return (unsigned)__builtin_amdgcn_s_getreg((3 << 11) | 20) & 0xFu; }
#define XB_SPIN(cond, bar) do { unsigned _sp = 0; while (cond) { __builtin_amdgcn_s_sleep(1); \
    if ((++_sp & 255u) == 0u) { if (xb_ld(&(bar)[XB_TMO])) break; if (_sp > XB_SPIN_CAP) { atomicAdd(&(bar)[XB_TMO], 1u); break; } } } } while (0)

struct XcdBarrier {
    unsigned* bar; unsigned x;
    volatile LAS unsigned* st;
};

__device__ __forceinline__ XcdBarrier xcd_barrier_post(unsigned* bar, volatile LAS unsigned* st) {
    XcdBarrier b; b.bar = bar; b.x = xb_xcc_id(); b.st = st;
    if (threadIdx.x == 0) (void)xb_add(&bar[XB_XCNT(b.x)], 1u);
    return b;
}
__device__ __forceinline__ void xcd_barrier_complete(unsigned* bar, unsigned x, unsigned& nloc, unsigned& nx) {
    const unsigned G = gridDim.x * gridDim.y * gridDim.z;
    unsigned sum, cnt, mine, sp = 0u;
    for (;;) {
        sum = 0u; cnt = 0u; mine = 0u;
#pragma unroll
        for (unsigned j = 0; j < 16; ++j) { const unsigned c = xb_ld(&bar[XB_XCNT(j)]); sum += c; cnt += (c > 0u) ? 1u : 0u; mine = (j == x) ? c : mine; }
        if (sum == G) break;
        __builtin_amdgcn_s_sleep(1);
        if ((++sp & 255u) == 0u) { if (xb_ld(&bar[XB_TMO])) break; if (sp > XB_SPIN_CAP) { atomicAdd(&bar[XB_TMO], 1u); break; } }
    }
    nloc = mine > 0u ? mine : 1u; nx = cnt > 0u ? cnt : 1u;
}

__device__ __forceinline__ void xcd_barrier(const XcdBarrier& b) {
    asm volatile("s_waitcnt vmcnt(0)" ::: "memory");
    __syncthreads();
    if (threadIdx.x == 0) {
        unsigned* bar = b.bar;
        __builtin_amdgcn_s_waitcnt(0);
        unsigned nloc = b.st[0], nx = b.st[1];
        if (nloc == 0u) { xcd_barrier_complete(bar, b.x, nloc, nx); b.st[0] = nloc; b.st[1] = nx; }
        const unsigned old = xb_add(&bar[XB_XSUB(b.x)], 1u);
        const unsigned gen = old / nloc;
        if (old + 1u == (gen + 1u) * nloc) {
            __builtin_amdgcn_fence(__ATOMIC_RELEASE, "agent");
            asm volatile("s_waitcnt vmcnt(0)" ::: "memory");
            const unsigned og = xb_add(&bar[XB_TOP], 1u);
            const unsigned tg = og / nx;
            if (og + 1u == (tg + 1u) * nx) xb_add(&bar[XB_TOPGEN], 1u);
            else XB_SPIN(xb_ld(&bar[XB_TOPGEN]) == tg, bar);
            __builtin_amdgcn_fence(__ATOMIC_ACQUIRE, "agent");
            xb_add(&bar[XB_XGEN(b.x)], 1u);
            asm volatile("s_waitcnt vmcnt(0)" ::: "memory");
        } else {
            XB_SPIN(xb_ld(&bar[XB_XGEN(b.x)]) == gen, bar);
            __builtin_amdgcn_fence(__ATOMIC_ACQUIRE, "agent");
            asm volatile("s_waitcnt vmcnt(0)" ::: "memory");
        }
    }
    __syncthreads();
}

struct Frame {
    LAS unsigned char* lds;
    int tid, lane, wave, G;
    float* out; unsigned char* ws;
};
struct Args { const float* in[38]; float* out; unsigned char* ws; int ph_lo, ph_hi, li, pad; int rep_s, rep_p; };
__device__ __forceinline__ __attribute__((address_space(1))) unsigned char* ws_fresh(unsigned char* p) { unsigned long long a = (unsigned long long)p; asm volatile("" : "+s"(a)); return (__attribute__((address_space(1))) unsigned char*)a; }
#define WSP(T, off) ((T*)(ws_fresh(F.ws) + (off)))

__device__ __forceinline__ void tr_item(const float* W, int ldw, int coff, int K, int Ncols, bf16* WT, int mode, int hf, int roff, int item, int lane, LAS float* scr) {
    const int nblk = Ncols / 32, kb = item / nblk, nb = item % nblk, k0 = 64 * kb, n0 = 32 * nb;
    float tv[32];
#pragma unroll
    for (int i = 0; i < 32; ++i) { const int kk = 2 * i + (lane >> 5); tv[i] = W[(size_t)(k0 + kk) * ldw + coff + n0 + (lane & 31)]; }
#pragma unroll
    for (int i = 0; i < 32; ++i) { const int kk = 2 * i + (lane >> 5); scr[kk * 33 + (lane & 31)] = tv[i]; }
    asm volatile("s_waitcnt lgkmcnt(0)" ::: "memory");
    const int c = lane & 7;
#pragma unroll
    for (int j = 0; j < 4; ++j) { const int n = (lane >> 3) + 8 * j; const LAS float* s = scr + (8 * c) * 33 + n; const int ng = n0 + n;
        const int drow = roff + (mode ? (256 * (ng >> 7) + 128 * hf + (ng & 127)) : ng);
        v4u o; o.x = pk2(s[0 * 33], s[1 * 33]); o.y = pk2(s[2 * 33], s[3 * 33]); o.z = pk2(s[4 * 33], s[5 * 33]); o.w = pk2(s[6 * 33], s[7 * 33]);
        *(v4u*)(WT + (size_t)drow * K + k0 + 8 * c) = o; }
    asm volatile("s_waitcnt lgkmcnt(0)" ::: "memory");
}
__device__ __forceinline__ void p0a_prologue(Frame& F, const Args& A) {
    LAS float* scr = (LAS float*)(F.lds + F.wave * 16384);
    const int gw = blockIdx.x * NWAVES + F.wave, NGW = F.G * NWAVES;
    constexpr int I_ADA = 16 * 192;
    for (int it = gw; it < 4 * I_ADA; it += NGW) { const int l = it / I_ADA, r = it - l * I_ADA; tr_item(A.in[8] + (size_t)l * 1024 * 6144, 6144, 0, 1024, 6144, WSP(bf16, WS_WADA), 0, 0, l * 6144, r, F.lane, scr); }
    const size_t gt = (size_t)blockIdx.x * NTHR + F.tid, NGT = (size_t)F.G * NTHR;
    for (size_t i = gt; i < (size_t)256 * 1024 / 4; i += NGT) { const int r = (int)(i >> 8), c4 = (int)(i & 255) * 4; v2u o = (v2u){0u, 0u};
        if (r < NCOND) { const f32x4 v = r < 4 ? *(const f32x4*)(A.in[6] + (size_t)r * 1024 + c4) : *(const f32x4*)(A.in[7] + (size_t)(r - 4) * 1024 + c4);
            o.x = pk2(pg8::silu_f(v[0]), pg8::silu_f(v[1])); o.y = pk2(pg8::silu_f(v[2]), pg8::silu_f(v[3])); }
        *(v2u*)(WSP(bf16, WS_AADA) + (size_t)r * 1024 + c4) = o; }
}
__device__ __forceinline__ void p0b_items(Frame& F, const Args& A, int slot, int nslots) {
    LAS float* scr = (LAS float*)(F.lds + F.wave * 16384);
    const int gw = slot * NWAVES + F.wave, NGW = nslots * NWAVES;
    constexpr int I_GU = 16 * 88, I_DN = 44 * 32, I_IN = 16 * 128, I_OUT = 32 * 32, I_PW1 = 16 * 32, I_PW2 = 16 * 32, I_DOWN = 16 * 22, I_QR = 8 * 12;
    constexpr int NITEMS = 4 * (2 * I_GU + I_DN) + 2 * (I_IN + I_OUT) + 2 * I_PW1 + I_PW2 + I_DOWN + I_QR;
    for (int it = gw; it < NITEMS; it += NGW) {
        int r = it; bool done = false;
#pragma unroll
        for (int l = 0; l < 4; ++l) {
            if (!done && r >= 0 && r < I_GU) { tr_item(A.in[14] + (size_t)l * 1024 * FF, FF, 0, 1024, FF, WSP(bf16, WS_WGU + l * SZ_WGU), 1, 0, 0, r, F.lane, scr); done = true; } r -= I_GU;
            if (!done && r >= 0 && r < I_GU) { tr_item(A.in[15] + (size_t)l * 1024 * FF, FF, 0, 1024, FF, WSP(bf16, WS_WGU + l * SZ_WGU), 1, 1, 0, r, F.lane, scr); done = true; } r -= I_GU;
            if (!done && r >= 0 && r < I_DN) { tr_item(A.in[16] + (size_t)l * FF * 1024, 1024, 0, FF, 1024, WSP(bf16, WS_WDN + l * SZ_WDN), 0, 0, 0, r, F.lane, scr); done = true; } r -= I_DN; }
#pragma unroll
        for (int j = 0; j < 2; ++j) {
            if (!done && r >= 0 && r < I_IN) { tr_item(A.in[17] + (size_t)j * 1024 * 4096, 4096, 0, 1024, 4096, WSP(bf16, WS_WIN + j * SZ_WIN), 0, 0, 0, r, F.lane, scr); done = true; } r -= I_IN;
            if (!done && r >= 0 && r < I_OUT) { tr_item(A.in[22] + (size_t)j * 2048 * 1024, 1024, 0, 2048, 1024, WSP(bf16, WS_WOUT + j * SZ_WOUT), 0, 0, 0, r, F.lane, scr); done = true; } r -= I_OUT; }
        if (!done && r >= 0 && r < I_PW1) { tr_item(A.in[23], 2048, 0, 1024, 1024, WSP(bf16, WS_WPW1), 1, 0, 0, r, F.lane, scr); done = true; } r -= I_PW1;
        if (!done && r >= 0 && r < I_PW1) { tr_item(A.in[23], 2048, 1024, 1024, 1024, WSP(bf16, WS_WPW1), 1, 1, 0, r, F.lane, scr); done = true; } r -= I_PW1;
        if (!done && r >= 0 && r < I_PW2) { tr_item(A.in[29], 1024, 0, 1024, 1024, WSP(bf16, WS_WPW2), 0, 0, 0, r, F.lane, scr); done = true; } r -= I_PW2;
        if (!done && r >= 0 && r < I_DOWN) { tr_item(A.in[31], 704, 0, 1024, 704, WSP(bf16, WS_WDOWN), 0, 0, 0, r, F.lane, scr); done = true; } r -= I_DOWN;
        if (!done && r >= 0 && r < I_QR) { const int head = r / 12; tr_item(A.in[34], 1536, head * 192 + 128, 384, 64, WSP(bf16, WS_WQC), 0, 0, 2048 + head * 64, r - head * 12, F.lane, scr); done = true; }
    }
    for (int u = slot; u < 256; u += nslots) { const int h = u >> 5, dt = (u >> 1) & 15, chf = u & 1, d = dt * 64 + F.lane; float bcol[128];
        const float* bp = A.in[37] + (size_t)h * 128 * 1024 + d;
#pragma unroll
        for (int v = 0; v < 128; ++v) bcol[v] = bp[(size_t)v * 1024];
        unsigned ow[8];
#pragma unroll 1
        for (int i2 = 0; i2 < 8; ++i2) { float acc2[2];
#pragma unroll
            for (int ii = 0; ii < 2; ++ii) { const int c = chf * 128 + F.wave * 16 + 2 * i2 + ii; const float* ap = A.in[36] + ((size_t)c * 8 + h) * 128;
                const int a0 = __float_as_int(ap[F.lane]), a1 = __float_as_int(ap[64 + F.lane]); float acc = 0.f;
#pragma unroll
                for (int v = 0; v < 64; ++v) acc += __int_as_float(__builtin_amdgcn_readlane(a0, v)) * bcol[v];
#pragma unroll
                for (int v = 0; v < 64; ++v) acc += __int_as_float(__builtin_amdgcn_readlane(a1, v)) * bcol[64 + v];
                acc2[ii] = acc; }
            const unsigned w = pk2(acc2[0], acc2[1]);
#pragma unroll
            for (int k = 0; k < 8; ++k) if (k == i2) ow[k] = w; }
        bf16* op = WSP(bf16, WS_WVO) + (size_t)d * 2048 + h * 256 + chf * 128 + F.wave * 16;
        *(v4u*)op = (v4u){ow[0], ow[1], ow[2], ow[3]}; *(v4u*)(op + 8) = (v4u){ow[4], ow[5], ow[6], ow[7]}; }
    for (int u = slot; u < 192; u += nslots) { const int h = u / 24, rt = (u % 24) >> 2, cq = u & 3, r = rt * 64 + F.lane; float brow[128];
        const f32x4* bp = (const f32x4*)(A.in[34] + (size_t)r * 1536 + h * 192);
#pragma unroll
        for (int k = 0; k < 32; ++k) { const f32x4 x = bp[k]; brow[4 * k] = x[0]; brow[4 * k + 1] = x[1]; brow[4 * k + 2] = x[2]; brow[4 * k + 3] = x[3]; }
#pragma unroll 1
        for (int i = 0; i < 8; ++i) { const int c = cq * 64 + F.wave * 8 + i; const float* ap = A.in[35] + ((size_t)c * 8 + h) * 128;
            const int a0 = __float_as_int(ap[F.lane]), a1 = __float_as_int(ap[64 + F.lane]); float acc = 0.f;
#pragma unroll
            for (int n = 0; n < 64; ++n) acc += __int_as_float(__builtin_amdgcn_readlane(a0, n)) * brow[n];
#pragma unroll
            for (int n = 0; n < 64; ++n) acc += __int_as_float(__builtin_amdgcn_readlane(a1, n)) * brow[64 + n];
            WSP(bf16, WS_WQC)[((size_t)h * 256 + c) * 384 + r] = (bf16)(pk2(acc, 0.f) & 0xffffu); } }
    const size_t gt = (size_t)slot * NTHR + F.tid, NGT = (size_t)nslots * NTHR;
    for (size_t i = gt; i < (size_t)64 * 1024 / 8; i += NGT) *(v4u*)(WSP(bf16, WS_WDOWN) + (size_t)704 * 1024 + i * 8) = (v4u){0u, 0u, 0u, 0u};
    for (size_t i = gt; i < (size_t)4104 * 32; i += NGT) { const int pi = (int)(i >> 5), d = (int)(i & 31); const double pos = pi < 4096 ? (double)pi : (double)(8192 + pi - 4096);
        const double inv = exp2(-(double)d * (13.287712379549449 / 32.0)); const double ang = pos * inv; double sn, cs; sincos(ang, &sn, &cs);
        WSP(f32x2, WS_ROPE)[i] = (f32x2){(float)cs, (float)sn}; }
    for (size_t i = gt; i < (size_t)128 * 22 * 256; i += NGT) { const int b = (int)(i / (22 * 256)), rem = (int)(i % (22 * 256));
        *(f32x4*)(F.out + O_CONV_S + (size_t)b * 30 * 1024 + (size_t)rem * 4) = *(const f32x4*)(A.in[4] + ((size_t)b * 30 + 8) * 1024 + (size_t)rem * 4); }
}

__device__ __forceinline__ const float* xrow_in(Frame& F, const Args& A, int row) { return row < NP_ROWS ? A.in[0] + (size_t)row * 1024 : A.in[1] + (size_t)(row - NP_ROWS) * 1024; }
__device__ __forceinline__ void p2_first_h(Frame& F, const Args& A) {
    const int gw = blockIdx.x * NWAVES + F.wave, NGW = F.G * NWAVES;
    const float* mod = WSP(const float, WS_MOD);
    for (int row = gw; row < M_ROWS; row += NGW) { const float* xr = xrow_in(F, A, row); const float* mp = mod + (size_t)pg8::cond_of(row) * 6144;
#pragma unroll
        for (int j = 0; j < 4; ++j) { const int c = 4 * F.lane + 256 * j; const f32x4 v = *(const f32x4*)(xr + c), sh = *(const f32x4*)(mp + c), sc = *(const f32x4*)(mp + 1024 + c);
            const f32x4 h = v * (sc + 1.0f) + sh;
            *(v2u*)(WSP(bf16, WS_HBUF) + (size_t)row * 1024 + c) = (v2u){pk2(h[0], h[1]), pk2(h[2], h[3])}; } }
}
__device__ __forceinline__ void ln_phase(Frame& F, const float* g, const float* b, float* xout, const float* modp, const float* gate, const float* bias, int nks, bf16* hout, const float* xres) {
    const int gw = blockIdx.x * NWAVES + F.wave, NGW = F.G * NWAVES;
    const float* pre = WSP(const float, WS_PRE); const float* slab = WSP(const float, WS_SLAB);
    for (int row = gw; row < M_ROWS; row += NGW) { f32x4 v[4]; float s = 0.f; const int cond = pg8::cond_of(row);
        if (row < NP_ROWS) {
#pragma unroll
            for (int j = 0; j < 4; ++j) v[j] = *(const f32x4*)(pre + (size_t)row * 1024 + 4 * F.lane + 256 * j);
        } else {
#pragma unroll
            for (int j = 0; j < 4; ++j) { const int c = 4 * F.lane + 256 * j; f32x4 a = bias ? *(const f32x4*)(bias + c) : (f32x4){0.f, 0.f, 0.f, 0.f};
                for (int k = 0; k < nks; ++k) a += *(const f32x4*)(slab + ((size_t)k * NS_ROWS + (row - NP_ROWS)) * 1024 + c);
                v[j] = *(const f32x4*)(xres + (size_t)row * 1024 + c) * pg8::DN_ALPHA + *(const f32x4*)(gate + (size_t)cond * 6144 + c) * a; }
        }
#pragma unroll
        for (int j = 0; j < 4; ++j) s += (v[j][0] + v[j][1]) + (v[j][2] + v[j][3]);
        const float mean = wave_sum(s) * (1.f / 1024.f); float s2 = 0.f;
#pragma unroll
        for (int j = 0; j < 4; ++j) { v[j] = v[j] - mean; s2 += (v[j][0] * v[j][0] + v[j][1] * v[j][1]) + (v[j][2] * v[j][2] + v[j][3] * v[j][3]); }
        const float rstd = 1.0f / sqrtf(wave_sum(s2) * (1.f / 1024.f) + LN_EPS);
        const float* mp = modp ? modp + (size_t)cond * 6144 : nullptr;
#pragma unroll
        for (int j = 0; j < 4; ++j) { const int c = 4 * F.lane + 256 * j; const f32x4 x = v[j] * rstd * *(const f32x4*)(g + c) + *(const f32x4*)(b + c);
            *(f32x4*)(xout + (size_t)row * 1024 + c) = x;
            if (mp) { const f32x4 h = x * (*(const f32x4*)(mp + 1024 + c) + 1.0f) + *(const f32x4*)(mp + c);
                *(v2u*)(hout + (size_t)row * 1024 + c) = (v2u){pk2(h[0], h[1]), pk2(h[2], h[3])}; } } }
}

constexpr int VSTR = 544, WSTR = 272, SP_V = 0, SP_W = 128 * VSTR, SP_ST = SP_W + 128 * WSTR;
__device__ __forceinline__ void spatial_phase(Frame& F, const Args& A, int j) {
    const float* lng = A.in[18] + (size_t)j * GD; const float* lnb = A.in[19] + (size_t)j * GD; const float* ws = A.in[20] + (size_t)j * 8 * 128 * 128; const float* bs = A.in[21] + (size_t)j * 8 * 128;
    const bf16* U = WSP(const bf16, WS_U); bf16* UM = WSP(bf16, WS_UM); const bf16* V = WSP(const bf16, WS_V); const f32x2* stats = WSP(const f32x2, WS_STATS);
    float* gv_out = F.out + O_GV + (size_t)j * 1024 * 2048;
    const int fr = F.lane & 15, fq = F.lane >> 4;
    LAS f32x2* rst = (LAS f32x2*)(F.lds + SP_ST);
    for (int u = blockIdx.x; u < 136 * 8; u += F.G) { const int chunk = u >> 3, g = u & 7, row0 = chunk * 128; const bool smp = chunk >= 128;
        if (F.tid < 128) { const f32x2* sp = stats + (size_t)(row0 + F.tid) * 32; float s = 0.f, ss = 0.f;
#pragma unroll 8
            for (int k = 0; k < 32; ++k) { const f32x2 p = sp[k]; s += p.x; ss += p.y; }
            const float mean = s * (1.f / 2048.f), var = fmaxf(ss * (1.f / 2048.f) - mean * mean, 0.f); rst[F.tid] = (f32x2){mean, 1.0f / sqrtf(var + LN_EPS)}; }
#pragma unroll
        for (int i = 0; i < 4; ++i) { const int cid = F.tid + 512 * i, t = cid >> 4, s0 = (cid & 15) * 8; float w[8];
            if (!smp) { const f32x4 a = *(const f32x4*)(ws + ((size_t)g * 128 + t) * 128 + s0), b = *(const f32x4*)(ws + ((size_t)g * 128 + t) * 128 + s0 + 4);
#pragma unroll
                for (int e = 0; e < 4; ++e) { w[e] = (s0 + e <= t) ? a[e] : 0.f; w[4 + e] = (s0 + 4 + e <= t) ? b[e] : 0.f; } }
            else { const int tt = t & 7; const bool blk = (t >> 3) == (s0 >> 3); const f32x4 a = *(const f32x4*)(ws + ((size_t)g * 128 + tt) * 128), b = *(const f32x4*)(ws + ((size_t)g * 128 + tt) * 128 + 4);
#pragma unroll
                for (int e = 0; e < 4; ++e) { w[e] = (blk && e <= tt) ? a[e] : 0.f; w[4 + e] = (blk && 4 + e <= tt) ? b[e] : 0.f; } }
            *(LAS v4u*)(F.lds + SP_W + t * WSTR + s0 * 2) = (v4u){pk2(w[0], w[1]), pk2(w[2], w[3]), pk2(w[4], w[5]), pk2(w[6], w[7])}; }
        __syncthreads();
#pragma unroll
        for (int i = 0; i < 8; ++i) { const int cid = F.tid + 512 * i, r = cid >> 5, c8 = (cid & 31) * 8; const int col = g * 256 + c8;
            const v4u raw = *(const v4u*)(V + (size_t)(row0 + r) * 2048 + col); const f32x2 st = rst[r];
            const f32x4 g0 = *(const f32x4*)(lng + col), g1 = *(const f32x4*)(lng + col + 4), b0 = *(const f32x4*)(lnb + col), b1 = *(const f32x4*)(lnb + col + 4);
            float x[8] = {bflo(raw.x), bfhi(raw.x), bflo(raw.y), bfhi(raw.y), bflo(raw.z), bfhi(raw.z), bflo(raw.w), bfhi(raw.w)};
#pragma unroll
            for (int e = 0; e < 4; ++e) { x[e] = (x[e] - st.x) * st.y * g0[e] + b0[e]; x[4 + e] = (x[4 + e] - st.x) * st.y * g1[e] + b1[e]; }
            *(LAS v4u*)(F.lds + SP_V + r * VSTR + c8 * 2) = (v4u){pk2(x[0], x[1]), pk2(x[2], x[3]), pk2(x[4], x[5]), pk2(x[6], x[7])};
            if (smp) { float* op = gv_out + (size_t)(row0 - NP_ROWS + r) * 2048 + col; *(f32x4*)op = (f32x4){x[0], x[1], x[2], x[3]}; *(f32x4*)(op + 4) = (f32x4){x[4], x[5], x[6], x[7]}; } }
        __syncthreads();
        bf16x8 af[2][4];
#pragma unroll
        for (int ct = 0; ct < 2; ++ct)
#pragma unroll
            for (int ks = 0; ks < 4; ++ks) { const LAS unsigned char* p0 = F.lds + SP_V + (32 * ks + 8 * fq + (fr >> 2)) * VSTR + (32 * F.wave + 16 * ct) * 2 + 8 * (fr & 3);
                const v4i16 lo = lds_tr(p0), hi = lds_tr(p0 + 4 * VSTR); af[ct][ks] = (bf16x8){lo[0], lo[1], lo[2], lo[3], hi[0], hi[1], hi[2], hi[3]}; }
#pragma unroll
        for (int tt = 0; tt < 8; ++tt) { f32x4 acc[2] = {(f32x4){0.f, 0.f, 0.f, 0.f}, (f32x4){0.f, 0.f, 0.f, 0.f}};
#pragma unroll
            for (int ks = 0; ks <= (tt >> 1); ++ks) { const bf16x8 bfr = *(const LAS bf16x8*)(F.lds + SP_W + (16 * tt + fr) * WSTR + (32 * ks + 8 * fq) * 2);
                acc[0] = mfma16(af[0][ks], bfr, acc[0]); acc[1] = mfma16(af[1][ks], bfr, acc[1]); }
            const int t = 16 * tt + fr; const float bias = bs[g * 128 + (smp ? (t & 7) : t)];
#pragma unroll
            for (int ct = 0; ct < 2; ++ct) { const size_t uo = (size_t)(row0 + t) * 2048 + g * 256 + 32 * F.wave + 16 * ct + 4 * fq; const v2u uu = *(const v2u*)(U + uo);
                *(v2u*)(UM + uo) = (v2u){pk2(bflo(uu.x) * (acc[ct][0] + bias), bfhi(uu.x) * (acc[ct][1] + bias)), pk2(bflo(uu.y) * (acc[ct][2] + bias), bfhi(uu.y) * (acc[ct][3] + bias))}; } }
        __syncthreads();
    }
}

constexpr int DW_X = 0, DW_RED = 62 * 2048;
__device__ __forceinline__ void dwconv_phase(Frame& F, const Args& A) {
    const bf16* glu = WSP(const bf16, WS_GLU); bf16* co = WSP(bf16, WS_CONVO);
    const float* wdw = A.in[25]; const float* bdw = A.in[26]; const float* lg = A.in[27]; const float* lb = A.in[28]; const float* stc = A.in[4];
    {
        const int c2 = 2 * F.tid; float w0[31], w1[31];
#pragma unroll
        for (int k = 0; k < 31; ++k) { const f32x2 w = *(const f32x2*)(wdw + (size_t)k * 1024 + c2); w0[k] = w.x; w1[k] = w.y; }
        const f32x2 bb = *(const f32x2*)(bdw + c2), gg = *(const f32x2*)(lg + c2), be = *(const f32x2*)(lb + c2);
        LAS float* red = (LAS float*)(F.lds + DW_RED);
        for (int u = blockIdx.x; u < NP_ROWS / 32; u += F.G) { const int row0 = u * 32, t0 = row0 & 4095;
            for (int cid = F.tid; cid < 62 * 128; cid += NTHR) { const int r = cid >> 7, ch = cid & 127; v4u v = (v4u){0u, 0u, 0u, 0u};
                if (t0 - 30 + r >= 0) v = *(const v4u*)(glu + (size_t)(row0 - 30 + r) * 1024 + ch * 8);
                *(LAS v4u*)(F.lds + DW_X + r * 2048 + ch * 16) = v; }
            __syncthreads();
#pragma unroll 1
            for (int g = 0; g < 8; ++g) {
                float a0[4] = {bb.x, bb.x, bb.x, bb.x}, a1[4] = {bb.y, bb.y, bb.y, bb.y};
#pragma unroll
                for (int j = 0; j < 34; ++j) { const unsigned xv = *(const LAS unsigned*)(F.lds + DW_X + (4 * g + j) * 2048 + F.tid * 4); const float x0 = bflo(xv), x1 = bfhi(xv);
#pragma unroll
                    for (int i = 0; i < 4; ++i) { const int k = j - i; if (k >= 0 && k < 31) { a0[i] += w0[k] * x0; a1[i] += w1[k] * x1; } } }
                float rs[8];
#pragma unroll
                for (int i = 0; i < 4; ++i) { rs[i] = a0[i] + a1[i]; rs[4 + i] = a0[i] * a0[i] + a1[i] * a1[i]; }
#pragma unroll
                for (int i = 0; i < 8; ++i) rs[i] = wave_sum(rs[i]);
                LAS float* rp = red + (g & 1) * 64;
                if (F.lane == 0) {
#pragma unroll
                    for (int i = 0; i < 8; ++i) rp[F.wave * 8 + i] = rs[i]; }
                __syncthreads();
#pragma unroll
                for (int i = 0; i < 4; ++i) { float s = 0.f, ss = 0.f;
#pragma unroll
                    for (int wv = 0; wv < 8; ++wv) { s += rp[wv * 8 + i]; ss += rp[wv * 8 + 4 + i]; }
                    const float mean = s * (1.f / 1024.f), rstd = 1.0f / sqrtf(fmaxf(ss * (1.f / 1024.f) - mean * mean, 0.f) + LN_EPS);
                    const float y0 = pg8::silu_f((a0[i] - mean) * rstd * gg.x + be.x), y1 = pg8::silu_f((a1[i] - mean) * rstd * gg.y + be.y);
                    *(unsigned*)(co + (size_t)(row0 + 4 * g + i) * 1024 + c2) = pk2(y0, y1); }
            }
            __syncthreads();
        }
    }
    {
        const int gw = blockIdx.x * NWAVES + F.wave, NGW = F.G * NWAVES; const int c0 = 16 * F.lane;
        for (int row = NP_ROWS + gw; row < M_ROWS; row += NGW) { float y[16];
#pragma unroll
            for (int e = 0; e < 16; e += 4) { const f32x4 bb = *(const f32x4*)(bdw + c0 + e); y[e] = bb[0]; y[e + 1] = bb[1]; y[e + 2] = bb[2]; y[e + 3] = bb[3]; }
            const int t = (row - NP_ROWS) & 7, sb = (row - NP_ROWS) >> 3;
#pragma unroll 4
            for (int k = 0; k < 31; ++k) { float x[16]; const int idx = t + k;
                if (idx < 30) { const float* sp = stc + ((size_t)sb * 30 + idx) * 1024 + c0;
#pragma unroll
                    for (int e = 0; e < 16; e += 4) { const f32x4 q = *(const f32x4*)(sp + e); x[e] = q[0]; x[e + 1] = q[1]; x[e + 2] = q[2]; x[e + 3] = q[3]; } }
                else { const size_t gr = (size_t)NP_ROWS + sb * 8 + (idx - 30); const v4u a = *(const v4u*)(glu + gr * 1024 + c0), b = *(const v4u*)(glu + gr * 1024 + c0 + 8);
                    x[0] = bflo(a.x); x[1] = bfhi(a.x); x[2] = bflo(a.y); x[3] = bfhi(a.y); x[4] = bflo(a.z); x[5] = bfhi(a.z); x[6] = bflo(a.w); x[7] = bfhi(a.w);
                    x[8] = bflo(b.x); x[9] = bfhi(b.x); x[10] = bflo(b.y); x[11] = bfhi(b.y); x[12] = bflo(b.z); x[13] = bfhi(b.z); x[14] = bflo(b.w); x[15] = bfhi(b.w); }
#pragma unroll
                for (int e = 0; e < 16; e += 4) { const f32x4 w = *(const f32x4*)(wdw + (size_t)k * 1024 + c0 + e); y[e] += w[0] * x[e]; y[e + 1] += w[1] * x[e + 1]; y[e + 2] += w[2] * x[e + 2]; y[e + 3] += w[3] * x[e + 3]; } }
            float s = 0.f;
#pragma unroll
            for (int e = 0; e < 16; ++e) s += y[e];
            const float mean = wave_sum(s) * (1.f / 1024.f); float s2 = 0.f;
#pragma unroll
            for (int e = 0; e < 16; ++e) { y[e] -= mean; s2 += y[e] * y[e]; }
            const float rstd = 1.0f / sqrtf(wave_sum(s2) * (1.f / 1024.f) + LN_EPS);
            unsigned o[8];
#pragma unroll
            for (int e = 0; e < 16; e += 2) { const float a = pg8::silu_f(y[e] * rstd * lg[c0 + e] + lb[c0 + e]), b = pg8::silu_f(y[e + 1] * rstd * lg[c0 + e + 1] + lb[c0 + e + 1]); o[e >> 1] = pk2(a, b); }
            *(v4u*)(co + (size_t)row * 1024 + c0) = (v4u){o[0], o[1], o[2], o[3]}; *(v4u*)(co + (size_t)row * 1024 + c0 + 8) = (v4u){o[4], o[5], o[6], o[7]}; }
    }
}

__device__ __forceinline__ void mla_post_phase(Frame& F, const Args& A) {
    const int gw = blockIdx.x * NWAVES + F.wave, NGW = F.G * NWAVES;
    const float* dp = WSP(const float, WS_DPROJ); const float* gq = A.in[32]; const float* gkv = A.in[33]; const f32x2* rope = WSP(const f32x2, WS_ROPE);
    bf16* qlat = WSP(bf16, WS_QLAT); bf16* kc = WSP(bf16, WS_KC);
    for (int row = gw; row < M_ROWS; row += NGW) { const float* d = dp + (size_t)row * 768;
        float q[6]; float s = 0.f;
#pragma unroll
        for (int i = 0; i < 6; ++i) { q[i] = d[F.lane + 64 * i]; s += q[i] * q[i]; }
        const float rq = 1.0f / sqrtf(wave_sum(s) * (1.f / 384.f) + RMS_EPS);
#pragma unroll
        for (int i = 0; i < 6; ++i) qlat[(size_t)row * 384 + F.lane + 64 * i] = (bf16)(pk2(q[i] * rq * gq[F.lane + 64 * i], 0.f) & 0xffffu);
        const f32x4 c = *(const f32x4*)(d + 384 + 4 * F.lane); const float s2 = (c[0] * c[0] + c[1] * c[1]) + (c[2] * c[2] + c[3] * c[3]);
        const float rk = 1.0f / sqrtf(wave_sum(s2) * (1.f / 256.f) + RMS_EPS);
        const f32x4 ck = c * rk * *(const f32x4*)(gkv + 4 * F.lane);
        float* ockv = row < NP_ROWS ? F.out + O_CKV_P + (size_t)row * 256 : F.out + O_CKV_S + (size_t)(row - NP_ROWS) * 256;
        *(f32x4*)(ockv + 4 * F.lane) = ck; *(v2u*)(kc + (size_t)row * 320 + 4 * F.lane) = (v2u){pk2(ck[0], ck[1]), pk2(ck[2], ck[3])};
        if (F.lane < 32) { const float x1 = d[640 + F.lane], x2 = d[672 + F.lane]; const f32x2 cs = rope[(size_t)pg8::posidx_of(row) * 32 + F.lane];
            const float o1 = x1 * cs.x - x2 * cs.y, o2 = x2 * cs.x + x1 * cs.y;
            float* okr = row < NP_ROWS ? F.out + O_KR_P + (size_t)row * 64 : F.out + O_KR_S + (size_t)(row - NP_ROWS) * 64;
            okr[F.lane] = o1; okr[32 + F.lane] = o2;
            kc[(size_t)row * 320 + 256 + F.lane] = (bf16)(pk2(o1, 0.f) & 0xffffu); kc[(size_t)row * 320 + 288 + F.lane] = (bf16)(pk2(o2, 0.f) & 0xffffu); } }
}

constexpr int KSTR = 672, KIMG = 64 * KSTR;
template <int NKT>
__device__ __forceinline__ void attn_core(const LAS unsigned char* imgw, const bf16x8 (&qf)[10], f32x4 (&o)[16], float& m, float& l, int fr, int fq, bool domask, int key0, int limit) {
    f32x4 s[NKT];
    const LAS unsigned char* kb = imgw + fr * KSTR + fq * 16;
    bf16x8 kf[2][5];
#define KLOAD(buf, b) do { _Pragma("unroll") for (int i_ = 0; i_ < 5; ++i_) kf[buf][i_] = *(const LAS bf16x8*)(kb + (16 * ((b) >> 1)) * KSTR + (5 * ((b) & 1) + i_) * 64); } while (0)
    KLOAD(0, 0);
#pragma unroll
    for (int b = 0; b < 2 * NKT; ++b) {
        if (b + 1 < 2 * NKT) KLOAD((b + 1) & 1, b + 1);
        __builtin_amdgcn_sched_barrier(0);
        if ((b & 1) == 0) s[b >> 1] = (f32x4){0.f, 0.f, 0.f, 0.f};
#pragma unroll
        for (int i = 0; i < 5; ++i) s[b >> 1] = mfma16(kf[b & 1][i], qf[5 * (b & 1) + i], s[b >> 1]);
        __builtin_amdgcn_sched_barrier(0);
    }
#undef KLOAD
    const LAS unsigned char* vb = imgw + (4 * fq + (fr >> 2)) * KSTR + 8 * (fr & 3);
    v4i16 vlo[2][4], vhi[2][4];
#define VLOAD(buf, g) do { _Pragma("unroll") for (int c_ = 0; c_ < 4; ++c_) { vlo[buf][c_] = lds_tr(vb + (32 * ((g) >> 2)) * KSTR + (4 * ((g) & 3) + c_) * 32); vhi[buf][c_] = lds_tr(vb + (32 * ((g) >> 2) + 16) * KSTR + (4 * ((g) & 3) + c_) * 32); } } while (0)
    VLOAD(0, 0);
    if (domask) {
#pragma unroll
        for (int kt = 0; kt < NKT; ++kt)
#pragma unroll
            for (int i = 0; i < 4; ++i) if (key0 + 16 * kt + 4 * fq + i > limit) s[kt][i] = -1e30f; }
    float mx = s[0][0];
#pragma unroll
    for (int kt = 0; kt < NKT; ++kt)
#pragma unroll
        for (int i = 0; i < 4; ++i) mx = fmaxf(mx, s[kt][i]);
    mx = fmaxf(mx, __shfl_xor(mx, 16)); mx = fmaxf(mx, __shfl_xor(mx, 32));
    const float mn = fmaxf(m, mx), alpha = ex2(m - mn); m = mn; float ps = 0.f;
#pragma unroll
    for (int kt = 0; kt < NKT; ++kt)
#pragma unroll
        for (int i = 0; i < 4; ++i) { const float p = ex2(s[kt][i] - mn); s[kt][i] = p; ps += p; }
    l = l * alpha + ps;
    if (__any(alpha != 1.0f)) {
#pragma unroll
        for (int c = 0; c < 16; ++c) o[c] = o[c] * alpha; }
    bf16x8 pf[NKT / 2];
#pragma unroll
    for (int k2 = 0; k2 < NKT / 2; ++k2) { v4u pw; pw.x = pk2(s[2 * k2][0], s[2 * k2][1]); pw.y = pk2(s[2 * k2][2], s[2 * k2][3]); pw.z = pk2(s[2 * k2 + 1][0], s[2 * k2 + 1][1]); pw.w = pk2(s[2 * k2 + 1][2], s[2 * k2 + 1][3]);
        pf[k2] = __builtin_bit_cast(bf16x8, pw); }
    __builtin_amdgcn_sched_barrier(0);
    constexpr int NG = (NKT / 2) * 4;
#pragma unroll
    for (int g = 0; g < NG; ++g) {
        if (g + 1 < NG) VLOAD((g + 1) & 1, g + 1);
        __builtin_amdgcn_sched_barrier(0);
#pragma unroll
        for (int c = 0; c < 4; ++c) { const int cc = 4 * (g & 3) + c;
            o[cc] = mfma16((bf16x8){vlo[g & 1][c][0], vlo[g & 1][c][1], vlo[g & 1][c][2], vlo[g & 1][c][3], vhi[g & 1][c][0], vhi[g & 1][c][1], vhi[g & 1][c][2], vhi[g & 1][c][3]}, pf[g >> 2], o[cc]); }
        __builtin_amdgcn_sched_barrier(0);
    }
#undef VLOAD
}
__device__ __forceinline__ void load_qfrags(bf16x8 (&qf)[10], const bf16* qrow, int head, int fq, const f32x2* ropetab, int posidx) {
#pragma unroll
    for (int ks = 0; ks < 8; ++ks) qf[ks] = *(const bf16x8*)(qrow + head * 256 + 32 * ks + 8 * fq);
    const v4u a = *(const v4u*)(qrow + 2048 + head * 64 + 8 * fq), b = *(const v4u*)(qrow + 2048 + head * 64 + 32 + 8 * fq);
    const f32x2* tb = ropetab + (size_t)posidx * 32 + 8 * fq;
    const unsigned aw[4] = {a.x, a.y, a.z, a.w}, bw[4] = {b.x, b.y, b.z, b.w}; unsigned o1[4], o2[4];
#pragma unroll
    for (int e = 0; e < 4; ++e) { const f32x2 c0 = tb[2 * e], c1 = tb[2 * e + 1]; const float x1l = bflo(aw[e]), x1h = bfhi(aw[e]), x2l = bflo(bw[e]), x2h = bfhi(bw[e]);
        o1[e] = pk2(x1l * c0.x - x2l * c0.y, x1h * c1.x - x2h * c1.y); o2[e] = pk2(x2l * c0.x + x1l * c0.y, x2h * c1.x + x1h * c1.y); }
    qf[8] = __builtin_bit_cast(bf16x8, (v4u){o1[0], o1[1], o1[2], o1[3]}); qf[9] = __builtin_bit_cast(bf16x8, (v4u){o2[0], o2[1], o2[2], o2[3]});
}
__device__ __forceinline__ void attn_prompt_unit(Frame& F, int b, int qb) {
    const int fr = F.lane & 15, fq = F.lane >> 4, q0 = 16 * qb, NT = (q0 + 16 + 63) >> 6; const size_t rowbase = (size_t)b * 4096;
    const bf16* Q = WSP(const bf16, WS_Q); const bf16* KC = WSP(const bf16, WS_KC); bf16* CTX = WSP(bf16, WS_CTX);
    bf16x8 qf[10]; load_qfrags(qf, Q + (rowbase + q0 + fr) * 2560, F.wave, fq, WSP(const f32x2, WS_ROPE), q0 + fr);
    f32x4 o[16];
#pragma unroll
    for (int c = 0; c < 16; ++c) o[c] = (f32x4){0.f, 0.f, 0.f, 0.f};
    float m = -1e30f, l = 0.f;
    v4u st[5]; unsigned loff[5];
#pragma unroll
    for (int i = 0; i < 5; ++i) { const int cid = F.tid + 512 * i; loff[i] = (unsigned)((cid / 40) * KSTR + (cid % 40) * 16); }
    const unsigned goff = (unsigned)F.tid * 16u;
#define PLOAD(T) do { const char* tb_ = (const char*)(KC + (rowbase + 64 * (T)) * 320); _Pragma("unroll") for (int i = 0; i < 5; ++i) st[i] = *(const v4u*)(tb_ + i * 8192 + goff); } while (0)
#define PSTORE(buf) do { _Pragma("unroll") for (int i = 0; i < 5; ++i) *(LAS v4u*)(F.lds + (buf) * KIMG + loff[i]) = st[i]; } while (0)
    PLOAD(0); PSTORE(0); __syncthreads();
    for (int T = 0; T < NT; ++T) {
        if (T + 1 < NT) PLOAD(T + 1);
        attn_core<4>(F.lds + (T & 1) * KIMG, qf, o, m, l, fr, fq, T == NT - 1, 64 * T, q0 + fr);
        if (T + 1 < NT) PSTORE((T + 1) & 1);
        __syncthreads();
    }
#undef PLOAD
#undef PSTORE
    float lt = l + __shfl_xor(l, 16); lt += __shfl_xor(lt, 32); const float inv = 1.0f / lt;
    bf16* op = CTX + (rowbase + q0 + fr) * 2048 + F.wave * 256 + 4 * fq;
#pragma unroll
    for (int c = 0; c < 16; ++c) *(v2u*)(op + 16 * c) = (v2u){pk2(o[c][0] * inv, o[c][1] * inv), pk2(o[c][2] * inv, o[c][3] * inv)};
}
__device__ __forceinline__ void attn_sample_unit(Frame& F, const Args& A, int b, int sp) {
    const int fr = F.lane & 15, fq = F.lane >> 4, j = F.wave & 3, kh = F.wave >> 2, head = 2 * j + (fr >> 3), tok = fr & 7;
    const bf16* Q = WSP(const bf16, WS_Q); const bf16* KC = WSP(const bf16, WS_KC);
    const float* cckv = A.in[2]; const float* ckr = A.in[3]; const int* ptab = (const int*)A.in[5] + b * 64 + 32 * sp;
    bf16x8 qf[10]; load_qfrags(qf, Q + ((size_t)NP_ROWS + b * 8 + tok) * 2560, head, fq, WSP(const f32x2, WS_ROPE), 4096 + tok);
    f32x4 o[16];
#pragma unroll
    for (int c = 0; c < 16; ++c) o[c] = (f32x4){0.f, 0.f, 0.f, 0.f};
    float m = -1e30f, l = 0.f;
    f32x4 sc[8], sk[2];
#define SLOAD(T) do { const size_t kr0 = (size_t)ptab[(T) >> 1] * 128 + ((T) & 1) * 64; int t_ = F.tid; asm volatile("" : "+v"(t_)); \
        _Pragma("unroll") for (int i = 0; i < 8; ++i) { const int cid = t_ + 512 * i; sc[i] = __builtin_nontemporal_load((const f32x4*)(cckv + (kr0 + (cid >> 6)) * 256 + (cid & 63) * 4)); } \
        _Pragma("unroll") for (int i = 0; i < 2; ++i) { const int cid = t_ + 512 * i; sk[i] = __builtin_nontemporal_load((const f32x4*)(ckr + (kr0 + (cid >> 4)) * 64 + (cid & 15) * 4)); } } while (0)
#define SSTORE(buf) do { int t_ = F.tid; asm volatile("" : "+v"(t_)); \
        _Pragma("unroll") for (int i = 0; i < 8; ++i) { const int cid = t_ + 512 * i; *(LAS v2u*)(F.lds + (buf) * KIMG + (cid >> 6) * KSTR + (cid & 63) * 8) = (v2u){pk2(sc[i][0], sc[i][1]), pk2(sc[i][2], sc[i][3])}; } \
        _Pragma("unroll") for (int i = 0; i < 2; ++i) { const int cid = t_ + 512 * i; *(LAS v2u*)(F.lds + (buf) * KIMG + (cid >> 4) * KSTR + 512 + (cid & 15) * 8) = (v2u){pk2(sk[i][0], sk[i][1]), pk2(sk[i][2], sk[i][3])}; } } while (0)
    SLOAD(0); SSTORE(0); __syncthreads();
    for (int T = 0; T < 64; ++T) {
        if (T + 1 < 64) SLOAD(T + 1);
        attn_core<2>(F.lds + (T & 1) * KIMG + 32 * kh * KSTR, qf, o, m, l, fr, fq, false, 0, 0);
        if (T + 1 < 64) SSTORE((T + 1) & 1);
        __syncthreads();
    }
#undef SLOAD
#undef SSTORE
    if (sp == 1) {
#pragma unroll
        for (int i = 0; i < 5; ++i) { const int cid = F.tid + 512 * i, r = cid / 40, ch = cid % 40; v4u v = (v4u){0u, 0u, 0u, 0u};
            if (r < 8) v = *(const v4u*)(KC + ((size_t)NP_ROWS + b * 8 + r) * 320 + ch * 8);
            *(LAS v4u*)(F.lds + r * KSTR + ch * 16) = v; }
        __syncthreads();
        attn_core<2>(F.lds + 32 * kh * KSTR, qf, o, m, l, fr, fq, true, 32 * kh, tok);
        __syncthreads();
    }
    LAS float* mg = (LAS float*)F.lds;
    if (kh == 1) {
#pragma unroll
        for (int c = 0; c < 16; ++c)
#pragma unroll
            for (int i = 0; i < 4; ++i) mg[(j * 66 + c * 4 + i) * 64 + F.lane] = o[c][i];
        mg[(j * 66 + 64) * 64 + F.lane] = m; mg[(j * 66 + 65) * 64 + F.lane] = l; }
    __syncthreads();
    if (kh == 0) { const float m2 = mg[(j * 66 + 64) * 64 + F.lane], l2 = mg[(j * 66 + 65) * 64 + F.lane]; const float mt = fmaxf(m, m2), a1 = ex2(m - mt), a2 = ex2(m2 - mt);
        float lt = l * a1 + l2 * a2; lt += __shfl_xor(lt, 16); lt += __shfl_xor(lt, 32);
        const size_t prow = ((size_t)b * 2 + sp) * 64 + 16 * j + fr; float* po = WSP(float, WS_PARTO) + prow * 256 + 4 * fq;
#pragma unroll
        for (int c = 0; c < 16; ++c) { f32x4 v;
#pragma unroll
            for (int i = 0; i < 4; ++i) v[i] = o[c][i] * a1 + mg[(j * 66 + c * 4 + i) * 64 + F.lane] * a2;
            *(f32x4*)(po + 16 * c) = v; }
        if (fq == 0) *(f32x2*)(WSP(float, WS_PARTML) + prow * 2) = (f32x2){mt, lt}; }
    __syncthreads();
}
__device__ __forceinline__ void attn_phase(Frame& F, const Args& A) {
    const int c = blockIdx.x;
    const int rs = A.rep_s, rp = A.rep_p;
    if (c & 1) for (int r_ = 0; r_ < rs; ++r_) for (int su = c; su < 256; su += F.G) attn_sample_unit(F, A, su >> 1, su & 1);
    for (int r_ = 0; r_ < rp; ++r_) for (int p = c; p < 512; p += F.G) { const int b = p >> 7, x = p & 127; attn_prompt_unit(F, b, x); attn_prompt_unit(F, b, 255 - x); }
    if (!(c & 1)) for (int r_ = 0; r_ < rs; ++r_) for (int su = c; su < 256; su += F.G) attn_sample_unit(F, A, su >> 1, su & 1);
}
__device__ __forceinline__ void attn_combine_phase(Frame& F) {
    const size_t gt = (size_t)blockIdx.x * NTHR + F.tid, NGT = (size_t)F.G * NTHR;
    const float* po = WSP(const float, WS_PARTO); const float* pml = WSP(const float, WS_PARTML); bf16* CTX = WSP(bf16, WS_CTX);
    for (size_t i = gt; i < (size_t)128 * 64 * 64; i += NGT) { const int b = (int)(i >> 12), r64 = (int)(i >> 6) & 63, d4 = (int)(i & 63) * 4;
        const size_t p0 = ((size_t)b * 2) * 64 + r64, p1 = p0 + 64; const f32x2 ml0 = *(const f32x2*)(pml + p0 * 2), ml1 = *(const f32x2*)(pml + p1 * 2);
        const float mt = fmaxf(ml0.x, ml1.x), a0 = ex2(ml0.x - mt), a1 = ex2(ml1.x - mt), inv = 1.0f / (ml0.y * a0 + ml1.y * a1);
        const f32x4 v = (*(const f32x4*)(po + p0 * 256 + d4) * a0 + *(const f32x4*)(po + p1 * 256 + d4) * a1) * inv;
        const int head = 2 * (r64 >> 4) + ((r64 & 15) >> 3), tok = r64 & 7;
        *(v2u*)(CTX + ((size_t)NP_ROWS + b * 8 + tok) * 2048 + head * 256 + d4) = (v2u){pk2(v[0], v[1]), pk2(v[2], v[3])}; }
}

__global__ void __launch_bounds__(NTHR, 2) mk_fwd(Args args) {
    extern __shared__ __attribute__((aligned(16))) unsigned char lds_raw[];
    Frame F;
    F.lds = (LAS unsigned char*)lds_raw;
    F.tid = threadIdx.x; F.lane = F.tid & 63; F.wave = __builtin_amdgcn_readfirstlane(F.tid >> 6); F.G = gridDim.x;
    const Args& A = args;
    F.out = args.out; F.ws = args.ws;
    volatile LAS unsigned* MISC = (volatile LAS unsigned*)(F.lds + MISC_OFF);
    for (int u = F.tid; u < (LDS_BYTES - RING_BYTES) / 4; u += NTHR) ((LAS unsigned*)(F.lds + RING_BYTES))[u] = 0u;
    __syncthreads();
    gu32* ctl = (gu32*)(F.ws + WS_CTL);
    XcdBarrier bar = xcd_barrier_post((unsigned*)(ctl + CW_BAR) + args.li * XCD_BAR_WORDS, MISC + 8);
    const int lo = args.ph_lo, hi = args.ph_hi;
#define IN(k) (lo <= (k) && (k) < hi)
#define REP(cls, ...) do { __VA_ARGS__; if (PROBE_CLS == (cls)) { __syncthreads(); __VA_ARGS__; } } while (0)
#define SEAM(k) do { if (IN(k) && IN((k) + 1)) xcd_barrier(bar); } while (0)
    const float* MOD = WSP(const float, WS_MOD);
#define MODP(layer, chunk) (MOD + (size_t)(layer) * NCOND * 6144 + (chunk) * 1024)
#define GEMM(EpiT, E, Aptr, Bptr, Mv, Nv, Kv) do { pg8::Gemm g_{(const pg8::bf16_t*)(Aptr), (const pg8::bf16_t*)(Bptr), (Mv), (Nv), (Kv), (Kv), (Kv)}; pg8::StaticOrder S_; S_.init((Mv), (Nv), F.G, (int)blockIdx.x); \
        pg8::gemm_phase<EpiT, pg8::StaticOrder, true, true>(F.lds, g_, S_, E); } while (0)
#define GEMM_RESID(LAYER, CHUNK, BIAS, Aptr, Bptr, Kv) do { pg8::EpiResid E_{((LAYER) == 0 && (CHUNK) == 2) ? A.in[0] : WSP(const float, WS_XRES), WSP(float, WS_PRE), MODP(LAYER, CHUNK), (BIAS)}; GEMM(pg8::EpiResid, E_, Aptr, Bptr, NP_ROWS, 1024, Kv); \
        pg8::Gemm g2_{(const pg8::bf16_t*)(Aptr), (const pg8::bf16_t*)(Bptr), M_ROWS, 1024, 256, (Kv), (Kv)}; pg8::SplitOrder S2_{NP_ROWS / 256, (Kv) / 256, F.G, (int)blockIdx.x}; pg8::EpiSlab E2_{WSP(float, WS_SLAB)}; \
        pg8::gemm_phase<pg8::EpiSlab, pg8::SplitOrder, true, true>(F.lds, g2_, S2_, E2_); } while (0)

    if (IN(0)) { REP(0, p0a_prologue(F, A)); } SEAM(0);
    if (IN(1)) { pg8::EpiAda E{WSP(float, WS_MOD), A.in[9]};
        REP(1, GEMM(pg8::EpiAda, E, WSP(bf16, WS_AADA), WSP(bf16, WS_WADA), 256, 24576, 1024); __syncthreads();
               if (F.G > 96) { if ((int)blockIdx.x >= 96) { p0b_items(F, A, 2 * ((int)blockIdx.x - 96), 2 * F.G - 96); p0b_items(F, A, 2 * ((int)blockIdx.x - 96) + 1, 2 * F.G - 96); } else p0b_items(F, A, 2 * (F.G - 96) + (int)blockIdx.x, 2 * F.G - 96); }
               else p0b_items(F, A, (int)blockIdx.x, F.G)); } SEAM(1);
    if (IN(2)) { REP(2, p2_first_h(F, A)); } SEAM(2);

#define FFN_PHASES(L, B) \
    if (IN(B)) { pg8::EpiSwiglu E{WSP(pg8::bf16_t, WS_ACT)}; REP(3, GEMM(pg8::EpiSwiglu, E, WSP(bf16, WS_HBUF), WSP(bf16, WS_WGU + (L) * SZ_WGU), M_ROWS, 2 * FF, 1024)); } SEAM(B); \
    if (IN((B) + 1)) { REP(4, GEMM_RESID(L, 5, nullptr, WSP(bf16, WS_ACT), WSP(bf16, WS_WDN + (L) * SZ_WDN), FF)); } SEAM((B) + 1); \
    if (IN((B) + 2)) { if (PROBE_CLS == 5) ln_phase(F, A.in[12] + (L) * 1024, A.in[13] + (L) * 1024, WSP(float, WS_DUMX), (L) == 3 ? nullptr : MODP((L) + 1, 0), MODP(L, 5), nullptr, FF / 256, WSP(bf16, WS_DUMH), WSP(const float, WS_XRES)); ln_phase(F, A.in[12] + (L) * 1024, A.in[13] + (L) * 1024, (L) == 3 ? F.out + O_Y : WSP(float, WS_XRES), (L) == 3 ? nullptr : MODP((L) + 1, 0), MODP(L, 5), nullptr, FF / 256, WSP(bf16, WS_HBUF), WSP(const float, WS_XRES)); } SEAM((B) + 2);
#define MIXLN_PHASE(L, B, BIAS, NKS) if (IN(B)) { if (PROBE_CLS == 5) ln_phase(F, A.in[10] + (L) * 1024, A.in[11] + (L) * 1024, WSP(float, WS_DUMX), MODP(L, 3), MODP(L, 2), (BIAS), (NKS), WSP(bf16, WS_DUMH), (L) == 0 ? A.in[1] - (size_t)NP_ROWS * 1024 : WSP(const float, WS_XRES)); ln_phase(F, A.in[10] + (L) * 1024, A.in[11] + (L) * 1024, WSP(float, WS_XRES), MODP(L, 3), MODP(L, 2), (BIAS), (NKS), WSP(bf16, WS_HBUF), (L) == 0 ? A.in[1] - (size_t)NP_ROWS * 1024 : WSP(const float, WS_XRES)); } SEAM(B);
#define GMLP_PHASES(L, J, B) \
    if (IN(B)) { pg8::EpiGmlpIn E{WSP(pg8::bf16_t, WS_U), WSP(pg8::bf16_t, WS_V), WSP(pg8::f32x2, WS_STATS)}; REP(6, GEMM(pg8::EpiGmlpIn, E, WSP(bf16, WS_HBUF), WSP(bf16, WS_WIN + (J) * SZ_WIN), M_ROWS, 4096, 1024)); } SEAM(B); \
    if (IN((B) + 1)) { REP(8, spatial_phase(F, A, J)); } SEAM((B) + 1); \
    if (IN((B) + 2)) { REP(7, GEMM_RESID(L, 2, nullptr, WSP(bf16, WS_UM), WSP(bf16, WS_WOUT + (J) * SZ_WOUT), 2048)); } SEAM((B) + 2);

    GMLP_PHASES(0, 0, 3)
    MIXLN_PHASE(0, 6, nullptr, 8)
    FFN_PHASES(0, 7)
    if (IN(10)) { pg8::EpiGlu E{WSP(pg8::bf16_t, WS_GLU), A.in[24], F.out + O_CONV_P, F.out + O_CONV_S}; REP(9, GEMM(pg8::EpiGlu, E, WSP(bf16, WS_HBUF), WSP(bf16, WS_WPW1), M_ROWS, 2048, 1024)); } SEAM(10);
    if (IN(11)) { REP(10, dwconv_phase(F, A)); } SEAM(11);
    if (IN(12)) { REP(11, GEMM_RESID(1, 2, A.in[30], WSP(bf16, WS_CONVO), WSP(bf16, WS_WPW2), 1024)); } SEAM(12);
    MIXLN_PHASE(1, 13, A.in[30], 4)
    FFN_PHASES(1, 14)
    if (IN(17)) { pg8::EpiF32 E{WSP(float, WS_DPROJ), 768}; REP(12, GEMM(pg8::EpiF32, E, WSP(bf16, WS_HBUF), WSP(bf16, WS_WDOWN), M_ROWS, 768, 1024)); } SEAM(17);
    if (IN(18)) { REP(13, mla_post_phase(F, A)); } SEAM(18);
    if (IN(19)) { pg8::EpiQ E{WSP(pg8::bf16_t, WS_Q), QSCALE}; REP(14, GEMM(pg8::EpiQ, E, WSP(bf16, WS_QLAT), WSP(bf16, WS_WQC), M_ROWS, 2560, 384)); } SEAM(19);
    if (IN(20)) { attn_phase(F, A); } SEAM(20);
    if (IN(21)) { REP(17, attn_combine_phase(F)); } SEAM(21);
    if (IN(22)) { REP(18, GEMM_RESID(2, 2, nullptr, WSP(bf16, WS_CTX), WSP(bf16, WS_WVO), 2048)); } SEAM(22);
    MIXLN_PHASE(2, 23, nullptr, 8)
    FFN_PHASES(2, 24)
    GMLP_PHASES(3, 1, 27)
    MIXLN_PHASE(3, 30, nullptr, 8)
    FFN_PHASES(3, 31)
#undef IN
#undef SEAM
}

extern "C" void kernel_launch(void* const* d_in, const int* in_sizes, int n_in, void* d_out, int out_size, void* d_ws, size_t ws_size, hipStream_t stream) {
    static int grid = 0;
    if (grid == 0) {
        if (n_in != 38 || (size_t)out_size != O_END || ws_size < WS_END) { fprintf(stderr, "kernel_launch: unexpected shapes (n_in %d, out %d, ws %zu)\n", n_in, out_size, ws_size); grid = -1; return; }
        int dev = 0, cus = 0, per_cu = 0;
        if (hipGetDevice(&dev) != hipSuccess || hipDeviceGetAttribute(&cus, hipDeviceAttributeMultiprocessorCount, dev) != hipSuccess) { grid = -1; return; }
        if (hipFuncSetAttribute((const void*)mk_fwd, hipFuncAttributeMaxDynamicSharedMemorySize, LDS_BYTES) != hipSuccess) { fprintf(stderr, "kernel_launch: hipFuncSetAttribute failed\n"); grid = -1; return; }
        if (hipOccupancyMaxActiveBlocksPerMultiprocessor(&per_cu, (const void*)mk_fwd, NTHR, LDS_BYTES) != hipSuccess || per_cu < 1) fprintf(stderr, "kernel_launch: occupancy query reports %d\n", per_cu);
        (void)hipGetLastError();
        grid = cus;
    }
    if (grid < 0) return;
    if (hipMemsetAsync((char*)d_ws + WS_CTL, 0, CTL_ZERO_BYTES, stream) != hipSuccess) return;
    Args a{};
    for (int i = 0; i < 38; ++i) a.in[i] = (const float*)d_in[i];
    a.out = (float*)d_out; a.ws = (unsigned char*)d_ws;
    a.rep_s = PROBE_CLS == 15 ? 2 : 1; a.rep_p = PROBE_CLS == 16 ? 2 : 1;
    constexpr int NL = MK_N_LAUNCHES;
    for (int li = 0; li < NL; ++li) {
        a.ph_lo = (int)((long)NPH * li / NL); a.ph_hi = (int)((long)NPH * (li + 1) / NL); a.li = li; a.pad = 0;
        hipLaunchKernelGGL(mk_fwd, dim3(grid), dim3(NTHR), LDS_BYTES, stream, a);
    }
}
```
